# Optimizing an MI355X kernel written in HIP

```python
import math
import jax
import jax.numpy as jnp
from jax import lax
import numpy as np

D_MODEL = 1024
BATCH = 8
SEQ = 2048
DEPTH = 2

CTX_LEN = 256
GRID_W = 64
N_BRANCH = 4
HEAD_DIM = 64
W_A = 512
CONV_K = 31
H_B = 8
W_B = H_B * HEAD_DIM
NA_ROWS = 8
NA_COLS = 16
H_C = 8
KV_C = 2
W_C = H_C * HEAD_DIM
W_C_KV = KV_C * HEAD_DIM
H_D = 4
W_D = H_D * 2 * HEAD_DIM
Q_BLOCK = 128
ROPE_THETA = 10000.0
EPS = 1e-6
NEG_INF = -1e30
IN_SIZES = (2 * W_A, W_A, 3 * W_B, W_B, W_C + 2 * W_C_KV, W_C, 3 * W_D, W_D, N_BRANCH * D_MODEL)
IN_W = 2 * W_A + W_A + 3 * W_B + W_B + W_C + 2 * W_C_KV + W_C + 3 * W_D + W_D + N_BRANCH * D_MODEL

kernel_name = 'hybrid_parallel_gated_dit_block'


def rms_norm(x, g):
    xf = x.astype(jnp.float32)
    y = xf * lax.rsqrt(jnp.mean(xf * xf, axis=-1, keepdims=True) + EPS)
    return (y * g.astype(jnp.float32)).astype(x.dtype)


def layer_norm(x, g, b):
    xf = x.astype(jnp.float32)
    mu = jnp.mean(xf, axis=-1, keepdims=True)
    var = jnp.mean(jnp.square(xf - mu), axis=-1, keepdims=True)
    y = (xf - mu) * lax.rsqrt(var + EPS)
    return (y * g.astype(jnp.float32) + b.astype(jnp.float32)).astype(x.dtype)


def grid_positions(t_len):
    t = jnp.arange(t_len)
    return (t // GRID_W).astype(jnp.float32), (t % GRID_W).astype(jnp.float32)


def rope_1d(x, pos):
    dr = x.shape[-1]
    freqs = ROPE_THETA ** (-jnp.arange(0, dr, 2, dtype=jnp.float32) / dr)
    ang = pos[:, None] * freqs[None, :]
    cos = jnp.cos(ang)[:, None, :].astype(x.dtype)
    sin = jnp.sin(ang)[:, None, :].astype(x.dtype)
    x1, x2 = jnp.split(x, 2, axis=-1)
    return jnp.concatenate([x1 * cos - x2 * sin, x2 * cos + x1 * sin], axis=-1)


def rope_2d(x, rows, cols):
    half = x.shape[-1] // 2
    return jnp.concatenate([rope_1d(x[..., :half], rows), rope_1d(x[..., half:], cols)], axis=-1)


def split_cols(p):
    return jnp.split(p, np.cumsum(IN_SIZES)[:-1].tolist(), axis=-1)


def blockwise(fn, q):
    b_, t = q.shape[:2]
    nb = t // Q_BLOCK
    qb = jnp.moveaxis(q.reshape(b_, nb, Q_BLOCK, *q.shape[2:]), 1, 0)
    out = lax.map(fn, qb)
    return jnp.moveaxis(out, 0, 1).reshape(b_, t, *out.shape[3:])


def grouped_attention(q, k, v):
    s = jnp.einsum('bqngd,bsnd->bngqs', q, k).astype(jnp.float32) * (q.shape[-1] ** -0.5)
    p = jax.nn.softmax(s, axis=-1).astype(v.dtype)
    return jnp.einsum('bngqs,bsnd->bqngd', p, v)


def diff_attention(q, k, v, lam):
    s = jnp.einsum('bqhtd,bkhtd->bhtqk', q, k).astype(jnp.float32) * (q.shape[-1] ** -0.5)
    p = jax.nn.softmax(s, axis=-1)
    a = (p[:, :, 0] - lam * p[:, :, 1]).astype(v.dtype)
    return jnp.einsum('bhqk,bkhe->bqhe', a, v)


def conformer_conv(u, conv_w, conv_b, ln_g, ln_b):
    a, g = jnp.split(u, 2, axis=-1)
    h = a * jax.nn.sigmoid(g)
    h = lax.conv_general_dilated(h, conv_w[:, None, :], window_strides=(1,),
                                 padding=[(CONV_K // 2, CONV_K // 2)],
                                 dimension_numbers=('NWC', 'WIO', 'NWC'),
                                 feature_group_count=W_A) + conv_b
    return jax.nn.silu(layer_norm(h, ln_g, ln_b))


def natten(q, k, v, kc, vc, rpb):
    b_, s_len, h_, hd = q.shape
    rows = s_len // GRID_W
    kr = min(NA_ROWS, rows)
    r = jnp.arange(rows)
    r0 = jnp.clip(r - kr // 2, 0, rows - kr)
    row_idx = r0[:, None] + jnp.arange(kr)[None, :]
    cq = jnp.arange(GRID_W)
    c0 = jnp.clip(cq - NA_COLS // 2, 0, GRID_W - NA_COLS)
    col_ok = (cq[None, :] >= c0[:, None]) & (cq[None, :] < c0[:, None] + NA_COLS)
    mask = jnp.broadcast_to(col_ok[:, None, :], (GRID_W, kr, GRID_W)).reshape(GRID_W, kr * GRID_W)
    dr = row_idx - r[:, None] + (NA_ROWS - 1)
    dc = jnp.clip(cq[None, :] - cq[:, None] + (NA_COLS - 1), 0, 2 * NA_COLS - 2)
    bias = rpb[:, dr[:, None, :, None], dc[None, :, None, :]]
    bias = bias.reshape(h_, rows, GRID_W, kr * GRID_W).astype(jnp.float32)
    qg = q.reshape(b_, rows, GRID_W, h_, hd)
    kband = k.reshape(b_, rows, GRID_W, h_, hd)[:, row_idx].reshape(b_, rows, kr * GRID_W, h_, hd)
    vband = v.reshape(b_, rows, GRID_W, h_, hd)[:, row_idx].reshape(b_, rows, kr * GRID_W, h_, hd)
    scale = hd ** -0.5
    s_lat = jnp.einsum('brqhd,brkhd->bhrqk', qg, kband).astype(jnp.float32) * scale + bias
    s_lat = jnp.where(mask, s_lat, NEG_INF)
    s_ctx = jnp.einsum('brqhd,blhd->bhrql', qg, kc).astype(jnp.float32) * scale
    p = jax.nn.softmax(jnp.concatenate([s_lat, s_ctx], axis=-1), axis=-1).astype(v.dtype)
    nk = kr * GRID_W
    o = (jnp.einsum('bhrqk,brkhd->brqhd', p[..., :nk], vband)
         + jnp.einsum('bhrql,blhd->brqhd', p[..., nk:], vc))
    return o.reshape(b_, s_len, h_ * hd)


def merge_branches(ya, yb, yc, yd, logits, b_merge, w_br_a, w_br_b, w_br_c, w_br_d, w_out):
    ga, gb, gc, gd = jnp.split(jax.nn.sigmoid(logits + b_merge), N_BRANCH, axis=-1)
    m = ga * (ya @ w_br_a) + gb * (yb @ w_br_b) + gc * (yc @ w_br_c) + gd * (yd @ w_br_d)
    return m @ w_out


def hybrid_layer(l, x, xc, c, c_ctx, need_ctx, w_ada, b_ada, norm_g, w_in, b_merge,
                 conv_w, conv_b, conv_ln_g, conv_ln_b, na_qn_g, na_kn_g, na_rpb,
                 gqa_qn_g, gqa_kn_g, diff_qn_g, diff_kn_g, lam_q1, lam_k1, lam_q2, lam_k2,
                 diff_subln_g, w_br_a, w_br_b, w_br_c, w_br_d, w_out):
    b_, s_len, _ = x.shape
    l_len = xc.shape[1]
    rows, cols = grid_positions(s_len)
    shift_x, scale_x, gate_x = jnp.split((jax.nn.silu(c) @ w_ada + b_ada)[:, None, :], 3, axis=-1)
    shift_c, scale_c, gate_c = jnp.split(jax.nn.silu(c_ctx) @ w_ada + b_ada, 3, axis=-1)
    h = rms_norm(x, norm_g) * (1.0 + scale_x) + shift_x
    hc = rms_norm(xc, norm_g) * (1.0 + scale_c) + shift_c
    a_in, a_gate, b_qkv, b_gate, c_qkv, c_gate, d_qkv, d_gate, logits = split_cols(h @ w_in)
    ca_in, ca_gate, cb_qkv, cb_gate, cc_qkv, cc_gate, cd_qkv, cd_gate, clogits = split_cols(hc @ w_in)

    y_a = conformer_conv(a_in, conv_w, conv_b, conv_ln_g, conv_ln_b) * jax.nn.silu(a_gate)

    qkv_b = b_qkv.reshape(b_, s_len, 3, H_B, HEAD_DIM)
    cqkv_b = cb_qkv.reshape(b_, l_len, 3, H_B, HEAD_DIM)
    kc_b = rms_norm(cqkv_b[:, :, 1], na_kn_g)
    vc_b = cqkv_b[:, :, 2]
    y_b = natten(rms_norm(qkv_b[:, :, 0], na_qn_g), rms_norm(qkv_b[:, :, 1], na_kn_g), qkv_b[:, :, 2],
                 kc_b, vc_b, na_rpb) * jax.nn.silu(b_gate)

    q_c = rope_2d(rms_norm(c_qkv[..., :W_C].reshape(b_, s_len, H_C, HEAD_DIM), gqa_qn_g), rows, cols)
    k_c = rope_2d(rms_norm(c_qkv[..., W_C:W_C + W_C_KV].reshape(b_, s_len, KV_C, HEAD_DIM), gqa_kn_g), rows, cols)
    v_c = c_qkv[..., W_C + W_C_KV:].reshape(b_, s_len, KV_C, HEAD_DIM)
    kc_c = rms_norm(cc_qkv[..., W_C:W_C + W_C_KV].reshape(b_, l_len, KV_C, HEAD_DIM), gqa_kn_g)
    vc_c = cc_qkv[..., W_C + W_C_KV:].reshape(b_, l_len, KV_C, HEAD_DIM)
    k_all_c = jnp.concatenate([k_c, kc_c], axis=1)
    v_all_c = jnp.concatenate([v_c, vc_c], axis=1)
    q_c = q_c.reshape(b_, s_len, KV_C, H_C // KV_C, HEAD_DIM)
    y_c = blockwise(lambda qi: grouped_attention(qi, k_all_c, v_all_c), q_c).reshape(b_, s_len, W_C)
    y_c = y_c * jax.nn.silu(c_gate)

    lam_init = 0.8 - 0.6 * math.exp(-0.3 * l)
    lam = (jnp.exp(jnp.sum(lam_q1.astype(jnp.float32) * lam_k1.astype(jnp.float32)))
           - jnp.exp(jnp.sum(lam_q2.astype(jnp.float32) * lam_k2.astype(jnp.float32))) + lam_init)
    qkv_d = d_qkv.reshape(b_, s_len, 3, H_D, 2, HEAD_DIM)
    q_d = rope_2d(rms_norm(qkv_d[:, :, 0], diff_qn_g).reshape(b_, s_len, 2 * H_D, HEAD_DIM), rows, cols)
    k_d = rope_2d(rms_norm(qkv_d[:, :, 1], diff_kn_g).reshape(b_, s_len, 2 * H_D, HEAD_DIM), rows, cols)
    q_d = q_d.reshape(b_, s_len, H_D, 2, HEAD_DIM)
    k_d = k_d.reshape(b_, s_len, H_D, 2, HEAD_DIM)
    v_d = qkv_d[:, :, 2].reshape(b_, s_len, H_D, 2 * HEAD_DIM)
    cqkv_d = cd_qkv.reshape(b_, l_len, 3, H_D, 2, HEAD_DIM)
    kc_d = rms_norm(cqkv_d[:, :, 1], diff_kn_g)
    vc_d = cqkv_d[:, :, 2].reshape(b_, l_len, H_D, 2 * HEAD_DIM)
    k_all_d = jnp.concatenate([k_d, kc_d], axis=1)
    v_all_d = jnp.concatenate([v_d, vc_d], axis=1)
    o_d = blockwise(lambda qi: diff_attention(qi, k_all_d, v_all_d, lam), q_d)
    y_d = (rms_norm(o_d, diff_subln_g) * (1.0 - lam_init)).reshape(b_, s_len, W_D) * jax.nn.silu(d_gate)

    x_out = x + gate_x * merge_branches(y_a, y_b, y_c, y_d, logits, b_merge,
                                        w_br_a, w_br_b, w_br_c, w_br_d, w_out)

    if need_ctx:
        yc_a = conformer_conv(ca_in, conv_w, conv_b, conv_ln_g, conv_ln_b) * jax.nn.silu(ca_gate)
        qc_b = rms_norm(cqkv_b[:, :, 0], na_qn_g)
        yc_b = grouped_attention(qc_b[:, :, :, None, :], kc_b, vc_b).reshape(b_, l_len, W_B)
        yc_b = yc_b * jax.nn.silu(cb_gate)
        qc_c = rms_norm(cc_qkv[..., :W_C].reshape(b_, l_len, H_C, HEAD_DIM), gqa_qn_g)
        qc_c = qc_c.reshape(b_, l_len, KV_C, H_C // KV_C, HEAD_DIM)
        yc_c = grouped_attention(qc_c, kc_c, vc_c).reshape(b_, l_len, W_C) * jax.nn.silu(cc_gate)
        qc_d = rms_norm(cqkv_d[:, :, 0], diff_qn_g)
        oc_d = diff_attention(qc_d, kc_d, vc_d, lam)
        yc_d = (rms_norm(oc_d, diff_subln_g) * (1.0 - lam_init)).reshape(b_, l_len, W_D) * jax.nn.silu(cd_gate)
        xc = xc + gate_c * merge_branches(yc_a, yc_b, yc_c, yc_d, clogits, b_merge,
                                          w_br_a, w_br_b, w_br_c, w_br_d, w_out)
    return x_out, xc


def setup_inputs(seed: int = 0) -> dict:
    key = jax.random.key(seed)
    ks = iter(jax.random.split(key, 40))

    def nrm(shape, s):
        return jax.random.normal(next(ks), shape, jnp.float32) * s

    def gain(shape):
        return 1.0 + nrm(shape, 0.02)

    L = DEPTH
    return {
        'x': nrm((BATCH, SEQ, D_MODEL), 1.0),
        'c': nrm((BATCH, D_MODEL), 1.0),
        'ctx': nrm((BATCH, CTX_LEN, D_MODEL), 1.0),
        'c_ctx': nrm((D_MODEL,), 1.0),
        'w_ada': nrm((L, D_MODEL, 3 * D_MODEL), D_MODEL ** -0.5),
        'b_ada': nrm((L, 3 * D_MODEL), 0.02),
        'norm_g': gain((L, D_MODEL)),
        'w_in': nrm((L, D_MODEL, IN_W), D_MODEL ** -0.5),
        'b_merge': nrm((L, N_BRANCH * D_MODEL), 0.02),
        'conv_w': nrm((L, CONV_K, W_A), CONV_K ** -0.5),
        'conv_b': nrm((L, W_A), 0.02),
        'conv_ln_g': gain((L, W_A)),
        'conv_ln_b': nrm((L, W_A), 0.02),
        'na_qn_g': gain((L, HEAD_DIM)),
        'na_kn_g': gain((L, HEAD_DIM)),
        'na_rpb': nrm((L, H_B, 2 * NA_ROWS - 1, 2 * NA_COLS - 1), 0.1),
        'gqa_qn_g': gain((L, HEAD_DIM)),
        'gqa_kn_g': gain((L, HEAD_DIM)),
        'diff_qn_g': gain((L, HEAD_DIM)),
        'diff_kn_g': gain((L, HEAD_DIM)),
        'lam_q1': nrm((L, HEAD_DIM), 0.1),
        'lam_k1': nrm((L, HEAD_DIM), 0.1),
        'lam_q2': nrm((L, HEAD_DIM), 0.1),
        'lam_k2': nrm((L, HEAD_DIM), 0.1),
        'diff_subln_g': gain((L, 2 * HEAD_DIM)),
        'w_br_a': nrm((L, W_A, D_MODEL), W_A ** -0.5),
        'w_br_b': nrm((L, W_B, D_MODEL), W_B ** -0.5),
        'w_br_c': nrm((L, W_C, D_MODEL), W_C ** -0.5),
        'w_br_d': nrm((L, W_D, D_MODEL), W_D ** -0.5),
        'w_out': nrm((L, D_MODEL, D_MODEL), D_MODEL ** -0.5),
    }


def reference(x, c, ctx, c_ctx, w_ada, b_ada, norm_g, w_in, b_merge, conv_w, conv_b, conv_ln_g,
              conv_ln_b, na_qn_g, na_kn_g, na_rpb, gqa_qn_g, gqa_kn_g, diff_qn_g, diff_kn_g,
              lam_q1, lam_k1, lam_q2, lam_k2, diff_subln_g, w_br_a, w_br_b, w_br_c, w_br_d, w_out):
    xc = ctx
    for l in range(DEPTH):
        x, xc = hybrid_layer(l, x, xc, c, c_ctx, l < DEPTH - 1, w_ada[l], b_ada[l], norm_g[l], w_in[l],
                             b_merge[l], conv_w[l], conv_b[l], conv_ln_g[l], conv_ln_b[l], na_qn_g[l],
                             na_kn_g[l], na_rpb[l], gqa_qn_g[l], gqa_kn_g[l], diff_qn_g[l], diff_kn_g[l],
                             lam_q1[l], lam_k1[l], lam_q2[l], lam_k2[l], diff_subln_g[l], w_br_a[l],
                             w_br_b[l], w_br_c[l], w_br_d[l], w_out[l])
    return x
```

```cpp
#include <hip/hip_runtime.h>
#include <hip/hip_cooperative_groups.h>
#include <cstdio>
#include <cstdint>
namespace cg = cooperative_groups;
namespace pg8 {
#define PG8_LAS __attribute__((address_space(3)))
typedef unsigned short bf16_t;
typedef short bf16x8 __attribute__((ext_vector_type(8)));
typedef float f32x4 __attribute__((ext_vector_type(4)));
typedef unsigned u32x4 __attribute__((ext_vector_type(4)));
constexpr int BM = 256, BK = 64, HALF = 128, HTB = HALF * BK * 2  , STAGE_BYTES = 8 * HTB, NXCD = 8, WGM = 8;

__host__ __device__ __forceinline__ int lds_byte(int r, int c) { const int st = (r >> 4) * 2 + (c >> 5), rr = r & 15, cc = c & 31, ob = rr * 64 + cc * 2; return st * 1024 + (ob ^ (((ob >> 9) & 1) << 5)); }
__host__ __device__ __forceinline__ void stage_rc(int b, int& R, int& C) { const int st = b / 1024, sb = b % 1024, swz = sb ^ (((sb >> 9) & 1) << 5); R = (st >> 1) * 16 + swz / 64; C = (st & 1) * 32 + (swz % 64) / 2; }
__host__ __device__ __forceinline__ int perm32(int rho) { const int n = rho >> 4, i = rho & 15; return 8 * (i >> 2) + 4 * n + (i & 3); }

struct Unit { int pm, pn; };
struct Gemm { const bf16_t* A; const bf16_t* Bt; int M, N, K, lda, acs; };

struct StaticOrder {
    int nM, nN, nwg, G, c;
    __host__ __device__ void init(int M, int N, int G_, int c_) { nM = M / BM; nN = N / BM; nwg = nM * nN; G = G_; c = c_; }
    __host__ __device__ bool next(int i, Unit& u) const {
        const long L = (long)i * G + c; if (L >= nwg) return false;
        int wgid = (int)L; { const int q = nwg / NXCD, r = nwg % NXCD, xcd = wgid % NXCD, off = wgid / NXCD; wgid = (xcd < r ? xcd * (q + 1) : r * (q + 1) + (xcd - r) * q) + off; }
        const int nig = WGM * nN, gid = wgid / nig, fm = gid * WGM, gsz = (nM - fm) < WGM ? (nM - fm) : WGM;
        u.pm = fm + ((wgid % nig) % gsz); u.pn = (wgid % nig) / gsz; return true;
    }
    __device__ __forceinline__ void a_ready(const Unit&) const {}
    __device__ __forceinline__ void done(const Unit&) const {}
};

template <class Epi, class Sched, bool ALIGN_EPI = false, bool SP2 = false>
__device__ __forceinline__ void gemm_phase(PG8_LAS unsigned char* lds, const Gemm g, const Sched& S, const Epi& E) {
    int tid = threadIdx.x; asm volatile("" : "+v"(tid)); const int wid = __builtin_amdgcn_readfirstlane(tid >> 6), lane = tid & 63, wr = wid >> 2, wc = wid & 3, fr = lane & 15, fq = lane >> 4;
    const int K = g.K, nt = K / BK;
    unsigned voffA[2], voffB[2];
#pragma unroll
    for (int i = 0; i < 2; ++i) { int R, C; stage_rc(tid * 16 + i * 8192, R, C); const int Rb = Epi::PERM ? ((R & ~31) + perm32(R & 31)) : R;
        voffA[i] = (unsigned)(R * g.lda + C) * 2u; voffB[i] = (unsigned)(Rb * K + C) * 2u; }
    const size_t kstep = (size_t)(BK * 2);
    const size_t hstep = (size_t)HALF * K * 2;
    const size_t tstep = 2 * hstep; const size_t hstepA = (size_t)HALF * g.lda * 2, tstepA = 2 * hstepA;
    const unsigned ldsw = (unsigned)wid * 1024u;
    const int aoff = lds_byte(wr * 64 + fr, fq * 8), boff = lds_byte(wc * 32 + fr, fq * 8);
#define PG8_SA(b, h) (((b) * 2 + (h)) * HTB)
#define PG8_SB(b, h) ((4 + (b) * 2 + (h)) * HTB)
#define PG8_STAGE(bufoff, gbase, voff) do { _Pragma("unroll") for (int _i = 0; _i < 2; ++_i) \
        __builtin_amdgcn_global_load_lds((const unsigned*)((const char*)(gbase) + (voff)[_i]), (PG8_LAS unsigned*)(lds + (bufoff) + ldsw + _i * 8192), 16, 0, 0); } while (0)
#define PG8_LDA(dst, b, h) do { _Pragma("unroll") for (int m = 0; m < 4; ++m) _Pragma("unroll") for (int k = 0; k < 2; ++k) dst[m][k] = *(const PG8_LAS bf16x8*)(lds + PG8_SA(b, h) + aoff + m * 2048 + k * 1024); } while (0)
#define PG8_LDB(dst, b, h) do { _Pragma("unroll") for (int n = 0; n < 2; ++n) _Pragma("unroll") for (int k = 0; k < 2; ++k) dst[n][k] = *(const PG8_LAS bf16x8*)(lds + PG8_SB(b, h) + boff + n * 2048 + k * 1024); } while (0)
#define PG8_MMA(ai, bj, At, Bt) do { __builtin_amdgcn_s_setprio(1); _Pragma("unroll") for (int m = 0; m < 4; ++m) _Pragma("unroll") for (int n = 0; n < 2; ++n) _Pragma("unroll") for (int k = 0; k < 2; ++k) \
        acc[ai][bj][m][n] = __builtin_amdgcn_mfma_f32_16x16x32_bf16(Bt[n][k], At[m][k], acc[ai][bj][m][n], 0, 0, 0); __builtin_amdgcn_s_setprio(0); } while (0)
#define PG8_WAIT_V(n) asm volatile("s_waitcnt vmcnt(" #n ")" ::: "memory")
#define PG8_WAIT_L(n) asm volatile("s_waitcnt lgkmcnt(" #n ")" ::: "memory")
#define PG8_BAR __builtin_amdgcn_s_barrier()
#define PG8_SCHED __builtin_amdgcn_sched_barrier(0)
    Unit cur, nxt; int ui = 0;
    if (!S.next(0, cur)) return;
    f32x4 acc[2][2][4][2];
#pragma unroll
    for (int a = 0; a < 2; ++a)
#pragma unroll
        for (int b = 0; b < 2; ++b)
#pragma unroll
            for (int m = 0; m < 4; ++m)
#pragma unroll
                for (int n = 0; n < 2; ++n) acc[a][b][m][n] = (f32x4){0.f, 0.f, 0.f, 0.f};
    bf16x8 At[4][2], B0[2][2], B1[2][2];
    const char* cA = (const char*)g.A + (size_t)cur.pm * tstepA + (size_t)(cur.pn >> 2) * g.acs; const char* cB = (const char*)g.Bt + (size_t)cur.pn * tstep;
    S.a_ready(cur);
    if constexpr (SP2) {
        PG8_STAGE(PG8_SB(0, 0), cB, voffB); PG8_STAGE(PG8_SB(0, 1), cB + hstep, voffB); PG8_STAGE(PG8_SA(0, 0), cA, voffA); PG8_STAGE(PG8_SA(0, 1), cA + hstepA, voffA);
        if (wr == 1) PG8_BAR;
        PG8_WAIT_V(2); PG8_BAR;
        PG8_STAGE(PG8_SB(1, 0), cB + kstep, voffB); PG8_STAGE(PG8_SA(1, 0), cA + kstep, voffA); PG8_STAGE(PG8_SB(1, 1), cB + hstep + kstep, voffB);
        PG8_WAIT_V(6); PG8_BAR;
    } else {
        PG8_STAGE(PG8_SB(0, 0), cB, voffB); PG8_STAGE(PG8_SA(0, 0), cA, voffA); PG8_STAGE(PG8_SB(0, 1), cB + hstep, voffB); PG8_STAGE(PG8_SA(0, 1), cA + hstepA, voffA);
        if (wr == 1) PG8_BAR;
        PG8_WAIT_V(4); PG8_BAR;
        PG8_STAGE(PG8_SB(1, 0), cB + kstep, voffB); PG8_STAGE(PG8_SA(1, 0), cA + kstep, voffA); PG8_STAGE(PG8_SB(1, 1), cB + hstep + kstep, voffB);
        PG8_WAIT_V(6); PG8_BAR;
    }
    for (;;) {
        const bool has_next = S.next(ui + 1, nxt);
        const char* nA = has_next ? (const char*)g.A + (size_t)nxt.pm * tstepA + (size_t)(nxt.pn >> 2) * g.acs : cA; const char* nB = has_next ? (const char*)g.Bt + (size_t)nxt.pn * tstep : cB;
        for (int t = 0; t < nt; t += 2) {
            const bool last = (t == nt - 2);
            const char* a1 = cA + (size_t)(t + 1) * kstep;
            const char* a2 = last ? nA : cA + (size_t)(t + 2) * kstep; const char* b2 = last ? nB : cB + (size_t)(t + 2) * kstep;
            const char* a3 = a2 + kstep; const char* b3 = b2 + kstep;
            if (last && has_next) S.a_ready(nxt);
            if constexpr (SP2) {
            PG8_LDB(B0, 0, 0); PG8_LDB(B1, 0, 1); PG8_SCHED; PG8_LDA(At, 0, 0); PG8_STAGE(PG8_SA(1, 1), a1 + hstepA, voffA);
            PG8_WAIT_V(8); PG8_WAIT_L(0); PG8_BAR; PG8_MMA(0, 0, At, B0); PG8_MMA(0, 1, At, B1); PG8_BAR; PG8_SCHED;
            PG8_LDA(At, 0, 1); PG8_STAGE(PG8_SB(0, 0), b2, voffB); PG8_STAGE(PG8_SB(0, 1), b2 + hstep, voffB); PG8_STAGE(PG8_SA(0, 0), a2, voffA);
            PG8_WAIT_V(8); PG8_WAIT_L(0); PG8_BAR; PG8_MMA(1, 0, At, B0); PG8_MMA(1, 1, At, B1); PG8_BAR; PG8_SCHED;
            PG8_LDB(B0, 1, 0); PG8_LDB(B1, 1, 1); PG8_SCHED; PG8_LDA(At, 1, 0); PG8_STAGE(PG8_SA(0, 1), a2 + hstepA, voffA);
            PG8_WAIT_V(8); PG8_WAIT_L(0); PG8_BAR; PG8_MMA(0, 0, At, B0); PG8_MMA(0, 1, At, B1); PG8_BAR; PG8_SCHED;
            PG8_LDA(At, 1, 1); PG8_STAGE(PG8_SB(1, 0), b3, voffB); PG8_STAGE(PG8_SB(1, 1), b3 + hstep, voffB); PG8_STAGE(PG8_SA(1, 0), a3, voffA);
            PG8_WAIT_V(8); PG8_WAIT_L(0); PG8_BAR; PG8_MMA(1, 0, At, B0); PG8_MMA(1, 1, At, B1); PG8_BAR; PG8_SCHED;
            } else {
            PG8_LDB(B0, 0, 0); PG8_SCHED; PG8_LDA(At, 0, 0); PG8_STAGE(PG8_SA(1, 1), a1 + hstepA, voffA);
            PG8_WAIT_L(8); PG8_BAR; PG8_WAIT_L(0); PG8_MMA(0, 0, At, B0); PG8_BAR; PG8_SCHED;
            PG8_LDB(B1, 0, 1); PG8_STAGE(PG8_SB(0, 0), b2, voffB);
            PG8_BAR; PG8_WAIT_L(0); PG8_MMA(0, 1, At, B1); PG8_BAR;
            PG8_LDA(At, 0, 1); PG8_STAGE(PG8_SA(0, 0), a2, voffA);
            PG8_BAR; PG8_WAIT_L(0); PG8_MMA(1, 0, At, B0); PG8_BAR; PG8_SCHED;
            PG8_STAGE(PG8_SB(0, 1), b2 + hstep, voffB);
            PG8_WAIT_V(6); PG8_BAR; PG8_MMA(1, 1, At, B1); PG8_BAR;
            PG8_LDB(B0, 1, 0); PG8_SCHED; PG8_LDA(At, 1, 0); PG8_STAGE(PG8_SA(0, 1), a2 + hstepA, voffA);
            PG8_WAIT_L(8); PG8_BAR; PG8_WAIT_L(0); PG8_MMA(0, 0, At, B0); PG8_BAR; PG8_SCHED;
            PG8_LDB(B1, 1, 1); PG8_STAGE(PG8_SB(1, 0), b3, voffB);
            PG8_BAR; PG8_WAIT_L(0); PG8_MMA(0, 1, At, B1); PG8_BAR;
            PG8_LDA(At, 1, 1); PG8_STAGE(PG8_SA(1, 0), a3, voffA);
            PG8_BAR; PG8_WAIT_L(0); PG8_MMA(1, 0, At, B0); PG8_BAR; PG8_SCHED;
            PG8_STAGE(PG8_SB(1, 1), b3 + hstep, voffB);
            PG8_WAIT_V(6); PG8_BAR; PG8_MMA(1, 1, At, B1); PG8_BAR;
            }
        }
        if constexpr (ALIGN_EPI) { if (wr == 0) PG8_BAR; }
        if constexpr (!Epi::AFTER_DRAIN) { E(acc, cur, wr, wc, fr, fq); S.done(cur); }
        if (!has_next) break;
#pragma unroll
        for (int a = 0; a < 2; ++a)
#pragma unroll
            for (int b = 0; b < 2; ++b)
#pragma unroll
                for (int m = 0; m < 4; ++m)
#pragma unroll
                    for (int n = 0; n < 2; ++n) acc[a][b][m][n] = (f32x4){0.f, 0.f, 0.f, 0.f};
        cur = nxt; cA = nA; cB = nB; ++ui;
        if constexpr (ALIGN_EPI) { if (wr == 1) PG8_BAR; }
    }
    PG8_WAIT_V(0);
    if constexpr (!ALIGN_EPI) { if (wr == 0) PG8_BAR; }
    PG8_BAR;
    if constexpr (Epi::AFTER_DRAIN) { E.fused(acc, cur, wr, wc, fr, fq, lds, wid, lane); S.done(cur); }
#undef PG8_SA
#undef PG8_SB
#undef PG8_STAGE
#undef PG8_LDA
#undef PG8_LDB
#undef PG8_MMA
#undef PG8_WAIT_V
#undef PG8_WAIT_L
#undef PG8_BAR
#undef PG8_SCHED
}
}

#ifndef MK_ONE
#define MK_ONE 1
#endif
#ifndef PROBE_KIND
#define PROBE_KIND (-1)
#endif
#ifndef PROBE_REP
#define PROBE_REP 0
#endif
#ifndef PROBE_VAR
#define PROBE_VAR 0
#endif
#define PROBE_LOOP(kind) _Pragma("unroll 1") for (int rep_ = 0; rep_ < ((PROBE_KIND == (kind)) ? 1 + PROBE_REP : 1); ++rep_)
#define LAS __attribute__((address_space(3)))
typedef unsigned short bf16_t;
typedef short bf16x8 __attribute__((ext_vector_type(8)));
typedef short s16x4 __attribute__((ext_vector_type(4)));
typedef float f32x4 __attribute__((ext_vector_type(4)));
typedef float f32x16 __attribute__((ext_vector_type(16)));
typedef unsigned u32x4 __attribute__((ext_vector_type(4)));
typedef unsigned u32x2 __attribute__((ext_vector_type(2)));
typedef LAS unsigned char lds_t;

constexpr int BATCH = 8, SEQ = 2048, DM = 1024, CTXL = 256, NLAT = BATCH * SEQ, NCTX = BATCH * CTXL, NTOK = NLAT + NCTX;
constexpr int INW = 11008, N1A = 6912, NLOG = 4096;
constexpr int QP = 4352;
constexpr int YP = 2048;
constexpr int KEYS = SEQ + CTXL, VTR = 1152;
constexpr float EPSN = 1e-6f;
constexpr float C2 = 0.125f * 1.4426950408889634f;
constexpr float LOG2E = 1.4426950408889634f;

constexpr size_t WS_MOD = 4096, WS_ROPE = 262144, WS_LAM = 300000, WS_BAR = 524288, WS_W = 1048576;
constexpr size_t SZ_WIN = (size_t)INW * DM * 2, SZ_WBR = (size_t)4 * DM * 512 * 2, SZ_WO = (size_t)DM * DM * 2;
constexpr size_t WS_WBR = WS_W + SZ_WIN, WS_WO = WS_WBR + SZ_WBR;
constexpr size_t WS_HN = WS_WO + SZ_WO;
constexpr size_t WS_VT = WS_HN + (size_t)NTOK * DM * 2;
constexpr size_t WS_QKV = WS_VT + (size_t)BATCH * VTR * KEYS * 2;
constexpr size_t WS_Y = WS_QKV + (size_t)NTOK * QP * 2;
constexpr size_t WS_XC1 = WS_Y + (size_t)NTOK * YP * 2;
constexpr size_t WS_END = WS_XC1 + (size_t)NCTX * DM * 4;
constexpr int LDS_BYTES = 147456;
constexpr int AT_ROPE = 132096;
constexpr int NPHASE = 15;

struct Args { const float* in[30]; float* out; unsigned char* ws; int ph_lo, ph_hi; };
typedef const __attribute__((address_space(4))) Args* KA;
__device__ __forceinline__ int opaque_tid() { int t = threadIdx.x; asm volatile("" : "+v"(t)); return t; }
__device__ __forceinline__ KA get_args() { KA p = (KA)__builtin_amdgcn_kernarg_segment_ptr(); asm volatile("" : "+s"(p)); return p; }

__device__ __forceinline__ float bf2f(unsigned h) { return __uint_as_float(h << 16); }
__device__ __forceinline__ unsigned pk2(float lo, float hi) { typedef float f2 __attribute__((ext_vector_type(2))); typedef __bf16 b2 __attribute__((ext_vector_type(2))); f2 v = {lo, hi}; b2 b = __builtin_convertvector(v, b2); return __builtin_bit_cast(unsigned, b); }
__device__ __forceinline__ unsigned f2bf(float f) { return pk2(f, 0.f) & 0xffffu; }
__device__ __forceinline__ float fexp2(float x) { return __builtin_amdgcn_exp2f(x); }
__device__ __forceinline__ float sigm(float x) { return __builtin_amdgcn_rcpf(1.f + fexp2(-x * LOG2E)); }
__device__ __forceinline__ float silu(float x) { return x * sigm(x); }
__device__ __forceinline__ float wave_sum(float v) {
#pragma unroll
    for (int o = 1; o < 64; o <<= 1) v += __shfl_xor(v, o);
    return v;
}
__device__ __forceinline__ void unpack8(u32x4 w, float* x) {
    x[0] = bf2f(w.x & 0xffffu); x[1] = __uint_as_float(w.x & 0xffff0000u); x[2] = bf2f(w.y & 0xffffu); x[3] = __uint_as_float(w.y & 0xffff0000u);
    x[4] = bf2f(w.z & 0xffffu); x[5] = __uint_as_float(w.z & 0xffff0000u); x[6] = bf2f(w.w & 0xffffu); x[7] = __uint_as_float(w.w & 0xffff0000u);
}
#define LDS_WAIT() asm volatile("s_waitcnt lgkmcnt(0)" ::: "memory")

#define XB_TMO      128
#define XB_XCNT(j)  (256  + 64 * (j))
#define XB_XSUB(j)  (1280 + 64 * (j))
#define XB_XGEN(j)  (2304 + 64 * (j))
#define XB_TOP      3328
#define XB_TOPGEN   3392
#define XCD_BAR_WORDS 3456
#define XB_SPIN_CAP (1u << 18)

__device__ __forceinline__ unsigned xb_ld(unsigned* p)              { return __hip_atomic_load(p, __ATOMIC_RELAXED, __HIP_MEMORY_SCOPE_AGENT); }
__device__ __forceinline__ unsigned xb_add(unsigned* p, unsigned v) { return __hip_atomic_fetch_add(p, v, __ATOMIC_RELAXED, __HIP_MEMORY_SCOPE_AGENT); }
__device__ __forceinline__ unsigned xb_xcc_id() { return (unsigned)__builtin_amdgcn_s_getreg((3 << 11) | 20) & 0xFu; }
#define XB_SPIN(cond, bar) do { unsigned _sp = 0; while (cond) { __builtin_amdgcn_s_sleep(1); \
    if ((++_sp & 255u) == 0u) { if (xb_ld(&(bar)[XB_TMO])) break; if (_sp > XB_SPIN_CAP) { atomicAdd(&(bar)[XB_TMO], 1u); break; } } } } while (0)

struct XcdBarrier {
    unsigned* bar; unsigned x;
    volatile LAS unsigned* st;
};

__device__ __forceinline__ XcdBarrier xcd_barrier_post(unsigned* bar, volatile LAS unsigned* st) {
    XcdBarrier b; b.bar = bar; b.x = xb_xcc_id(); b.st = st;
    if (threadIdx.x == 0) (void)xb_add(&bar[XB_XCNT(b.x)], 1u);
    return b;
}
__device__ __forceinline__ void xcd_barrier_complete(unsigned* bar, unsigned x, unsigned& nloc, unsigned& nx) {
    const unsigned G = gridDim.x * gridDim.y * gridDim.z;
    unsigned sum, cnt, mine, sp = 0u;
    for (;;) {
        sum = 0u; cnt = 0u; mine = 0u;
#pragma unroll
        for (unsigned j = 0; j < 16; ++j) { const unsigned c = xb_ld(&bar[XB_XCNT(j)]); sum += c; cnt += (c > 0u) ? 1u : 0u; mine = (j == x) ? c : mine; }
        if (sum == G) break;
        __builtin_amdgcn_s_sleep(1);
        if ((++sp & 255u) == 0u) { if (xb_ld(&bar[XB_TMO])) break; if (sp > XB_SPIN_CAP) { atomicAdd(&bar[XB_TMO], 1u); break; } }
    }
    nloc = mine > 0u ? mine : 1u; nx = cnt > 0u ? cnt : 1u;
}

__device__ __forceinline__ void xcd_barrier(const XcdBarrier& b) {
    asm volatile("s_waitcnt vmcnt(0)" ::: "memory");
    __syncthreads();
    if (threadIdx.x == 0) {
        unsigned* bar = b.bar;
        __builtin_amdgcn_s_waitcnt(0);
        unsigned nloc = b.st[0], nx = b.st[1];
        if (nloc == 0u) { xcd_barrier_complete(bar, b.x, nloc, nx); b.st[0] = nloc; b.st[1] = nx; }
        const unsigned old = xb_add(&bar[XB_XSUB(b.x)], 1u);
        const unsigned gen = old / nloc;
        if (old + 1u == (gen + 1u) * nloc) {
            __builtin_amdgcn_fence(__ATOMIC_RELEASE, "agent");
            asm volatile("s_waitcnt vmcnt(0)" ::: "memory");
            const unsigned og = xb_add(&bar[XB_TOP], 1u);
            const unsigned tg = og / nx;
            if (og + 1u == (tg + 1u) * nx) xb_add(&bar[XB_TOPGEN], 1u);
            else XB_SPIN(xb_ld(&bar[XB_TOPGEN]) == tg, bar);
            __builtin_amdgcn_fence(__ATOMIC_ACQUIRE, "agent");
            xb_add(&bar[XB_XGEN(b.x)], 1u);
            asm volatile("s_waitcnt vmcnt(0)" ::: "memory");
        } else {
            XB_SPIN(xb_ld(&bar[XB_XGEN(b.x)]) == gen, bar);
            __builtin_amdgcn_fence(__ATOMIC_ACQUIRE, "agent");
            asm volatile("s_waitcnt vmcnt(0)" ::: "memory");
        }
    }
    __syncthreads();
}

struct Epi1a {
    static constexpr bool PERM = true, AFTER_DRAIN = false;
    bf16_t* qkv; bf16_t* gates; int L; const lds_t* ldsb;
    __device__ __forceinline__ void operator()(const f32x4 (&acc)[2][2][4][2], const pg8::Unit& u, int wr, int wc, int fr, int fq) const {
        const int pn = u.pn; const int row0 = u.pm * 256 + wr * 64 + fr; const int cw = wc * 32 + 8 * fq;
        const bool headtile = (pn >= 6 && pn < 10) || (pn >= 14 && pn < 17) || (pn >= 19 && pn < 23);
        if (headtile) {
            KA a = get_args();
            const int cb = (pn < 12 ? 512 + (pn - 6) * 256 : (pn < 17 ? 2048 + (pn - 14) * 256 : 2816 + (pn - 19) * 256)) + 64 * wc;
            const bool plain = (pn == 16) && (wc >= 2);
            const int gi = pn < 8 ? 13 : (pn < 10 ? 14 : (pn < 16 ? 16 : (pn == 16 ? 17 : (pn < 21 ? 18 : 19))));
            const bool isq = (pn < 8) || (pn == 14) || (pn == 15) || (pn == 19) || (pn == 20);
            const bool rot = (pn >= 14) && (u.pm < 64);
            const int hh = fq >> 1, e0 = 32 * hh + 8 * (fq & 1);
            const float* gp = a->in[gi] + L * 64 + e0;
            const LAS float* rope = (const LAS float*)(ldsb + AT_ROPE) + 8 * (fq & 1);
            f32x4 g4[2][2];
#pragma unroll
            for (int bj = 0; bj < 2; ++bj)
#pragma unroll
                for (int n = 0; n < 2; ++n) g4[bj][n] = *(const f32x4*)(gp + 16 * bj + 4 * n);
            const float qs = isq ? C2 : 1.f;
#pragma unroll
            for (int ai = 0; ai < 2; ++ai)
#pragma unroll
                for (int m = 0; m < 4; ++m) {
                    const int row = row0 + ai * 128 + m * 16;
                    f32x4 v[2][2];
#pragma unroll
                    for (int bj = 0; bj < 2; ++bj)
#pragma unroll
                        for (int n = 0; n < 2; ++n) v[bj][n] = acc[ai][bj][m][n];
                    if (!plain) {
                        float ss = 0.f;
#pragma unroll
                        for (int bj = 0; bj < 2; ++bj)
#pragma unroll
                            for (int n = 0; n < 2; ++n) ss += (v[bj][n][0] * v[bj][n][0] + v[bj][n][1] * v[bj][n][1]) + (v[bj][n][2] * v[bj][n][2] + v[bj][n][3] * v[bj][n][3]);
                        ss += __shfl_xor(ss, 16); ss += __shfl_xor(ss, 32);
                        const float rstd = rsqrtf(ss * (1.f / 64.f) + EPSN) * qs;
#pragma unroll
                        for (int bj = 0; bj < 2; ++bj)
#pragma unroll
                            for (int n = 0; n < 2; ++n) v[bj][n] = v[bj][n] * rstd * g4[bj][n];
                        if (rot) {
                            const int t = row & (SEQ - 1); const int pos = hh == 0 ? (t >> 6) : (t & 63);
#pragma unroll
                            for (int n = 0; n < 2; ++n) {
                                const f32x4 cs = *(const LAS f32x4*)(rope + pos * 16 + 4 * n), sn = *(const LAS f32x4*)(rope + 1024 + pos * 16 + 4 * n);
                                const f32x4 x1 = v[0][n], x2 = v[1][n];
                                v[0][n] = x1 * cs - x2 * sn; v[1][n] = x2 * cs + x1 * sn; }
                        }
                    }
                    bf16_t* rowp = qkv + (size_t)row * QP + cb + e0;
#pragma unroll
                    for (int bj = 0; bj < 2; ++bj) { u32x4 w; w.x = pk2(v[bj][0][0], v[bj][0][1]); w.y = pk2(v[bj][0][2], v[bj][0][3]); w.z = pk2(v[bj][1][0], v[bj][1][1]); w.w = pk2(v[bj][1][2], v[bj][1][3]); *(u32x4*)(rowp + 16 * bj) = w; }
                    asm volatile("" ::: "memory");
                }
        } else if (pn < 4) {
            bf16_t* base = qkv + (size_t)row0 * QP + pn * 128 + cw;
#pragma unroll
            for (int ai = 0; ai < 2; ++ai)
#pragma unroll
                for (int m = 0; m < 4; ++m) {
                    const f32x4 a0 = acc[ai][0][m][0], a1 = acc[ai][0][m][1], g0 = acc[ai][1][m][0], g1 = acc[ai][1][m][1];
                    u32x4 w;
                    w.x = pk2(a0[0] * sigm(g0[0]), a0[1] * sigm(g0[1])); w.y = pk2(a0[2] * sigm(g0[2]), a0[3] * sigm(g0[3]));
                    w.z = pk2(a1[0] * sigm(g1[0]), a1[1] * sigm(g1[1])); w.w = pk2(a1[2] * sigm(g1[2]), a1[3] * sigm(g1[3]));
                    *(u32x4*)(base + (size_t)(ai * 128 + m * 16) * QP) = w;
                }
        } else {
            bf16_t* dst; int ldc, cb;
            if (pn < 6) { dst = gates; ldc = YP; cb = (pn - 4) * 256; }
            else if (pn < 12) { dst = qkv; ldc = QP; cb = 512 + (pn - 6) * 256; }
            else if (pn < 14) { dst = gates; ldc = YP; cb = 512 + (pn - 12) * 256; }
            else if (pn < 17) { dst = qkv; ldc = QP; cb = 2048 + (pn - 14) * 256; }
            else if (pn < 19) { dst = gates; ldc = YP; cb = 1024 + (pn - 17) * 256; }
            else if (pn < 25) { dst = qkv; ldc = QP; cb = 2816 + (pn - 19) * 256; }
            else { dst = gates; ldc = YP; cb = 1536 + (pn - 25) * 256; }
#pragma unroll
            for (int ai = 0; ai < 2; ++ai)
#pragma unroll
                for (int m = 0; m < 4; ++m) {
                    bf16_t* rowp = dst + (size_t)(row0 + ai * 128 + m * 16) * ldc + cb + cw;
#pragma unroll
                    for (int bj = 0; bj < 2; ++bj) {
                        const f32x4 v0 = acc[ai][bj][m][0], v1 = acc[ai][bj][m][1];
                        u32x4 w; w.x = pk2(v0[0], v0[1]); w.y = pk2(v0[2], v0[3]); w.z = pk2(v1[0], v1[1]); w.w = pk2(v1[2], v1[3]);
                        *(u32x4*)(rowp + bj * 128) = w;
                    }
                }
        }
    }
};
struct Epi1b {
    static constexpr bool PERM = true, AFTER_DRAIN = false;
    bf16_t* G; const float* bm;
    __device__ __forceinline__ void operator()(const f32x4 (&acc)[2][2][4][2], const pg8::Unit& u, int wr, int wc, int fr, int fq) const {
        const int row0 = u.pm * 256 + wr * 64 + fr; const int col0 = u.pn * 256 + wc * 32 + 8 * fq;
        f32x4 bv[2][2];
#pragma unroll
        for (int bj = 0; bj < 2; ++bj)
#pragma unroll
            for (int n = 0; n < 2; ++n) bv[bj][n] = *(const f32x4*)(bm + col0 + bj * 128 + 4 * n);
#pragma unroll
        for (int ai = 0; ai < 2; ++ai)
#pragma unroll
            for (int m = 0; m < 4; ++m) {
                bf16_t* rowp = G + ((((size_t)(u.pm * 16 + u.pn) * 8 + wr * 4 + wc) * 16 + (ai * 8 + m * 2)) * 64 + fq * 16 + fr) * 8;
#pragma unroll
                for (int bj = 0; bj < 2; ++bj) {
                    const f32x4 v0 = acc[ai][bj][m][0] + bv[bj][0], v1 = acc[ai][bj][m][1] + bv[bj][1];
                    u32x4 w; w.x = pk2(v0[0], v0[1]); w.y = pk2(v0[2], v0[3]); w.z = pk2(v1[0], v1[1]); w.w = pk2(v1[2], v1[3]);
                    *(u32x4*)(rowp + bj * 512) = w;
                }
            }
    }
};
struct EpiNull { static constexpr bool PERM = true, AFTER_DRAIN = false; float* sink;
    __device__ __forceinline__ void operator()(const f32x4 (&acc)[2][2][4][2], const pg8::Unit& u, int wr, int wc, int fr, int fq) const {
        float t = 0.f;
#pragma unroll
        for (int ai = 0; ai < 2; ++ai)
#pragma unroll
            for (int bj = 0; bj < 2; ++bj)
#pragma unroll
                for (int m = 0; m < 4; ++m)
#pragma unroll
                    for (int n = 0; n < 2; ++n) t += acc[ai][bj][m][n][0] + acc[ai][bj][m][n][1] + acc[ai][bj][m][n][2] + acc[ai][bj][m][n][3];
        if (t == 123.456f) *sink = t; }
};
struct MergeOrder {
    pg8::StaticOrder base;
    __device__ __forceinline__ bool next(int i, pg8::Unit& u) const { pg8::Unit t; if (!base.next(i >> 2, t)) return false; u.pm = t.pm; u.pn = (i & 3) * 4 + t.pn; return true; }
    __device__ __forceinline__ void a_ready(const pg8::Unit&) const {}
    __device__ __forceinline__ void done(const pg8::Unit&) const {}
};
struct EpiM {
    static constexpr bool PERM = true, AFTER_DRAIN = false;
    const bf16_t* G; bf16_t* mb; bf16_t* ps;
    __device__ __forceinline__ void operator()(const f32x4 (&acc)[2][2][4][2], const pg8::Unit& u, int wr, int wc, int fr, int fq) const {
        const int br = u.pn >> 2;
        const int row0 = u.pm * 256 + wr * 64 + fr; const int col0 = (u.pn & 3) * 256 + wc * 32 + 8 * fq;
#pragma unroll
        for (int ai = 0; ai < 2; ++ai) {
            u32x4 gq[4][2], mq[4][2];
#pragma unroll
            for (int m = 0; m < 4; ++m)
#pragma unroll
                for (int bj = 0; bj < 2; ++bj) { const size_t r = (size_t)(row0 + ai * 128 + m * 16);
                    gq[m][bj] = __builtin_nontemporal_load((const u32x4*)(G + ((((size_t)(u.pm * 16 + u.pn) * 8 + wr * 4 + wc) * 16 + (ai * 8 + m * 2 + bj)) * 64 + fq * 16 + fr) * 8));
                    mq[m][bj] = (br > 0) ? *(const u32x4*)(ps + ((((size_t)(u.pm * 4 + (u.pn & 3)) * 8 + wr * 4 + wc) * 16 + (ai * 8 + m * 2 + bj)) * 64 + fq * 16 + fr) * 8) : (u32x4){0u, 0u, 0u, 0u}; }
#pragma unroll
            for (int m = 0; m < 4; ++m)
#pragma unroll
                for (int bj = 0; bj < 2; ++bj) { const size_t r = (size_t)(row0 + ai * 128 + m * 16);
                    float g[8], o[8]; unpack8(gq[m][bj], g); unpack8(mq[m][bj], o);
#pragma unroll
                    for (int e = 0; e < 8; ++e) g[e] = sigm(g[e]);
                    const f32x4 v0 = acc[ai][bj][m][0], v1 = acc[ai][bj][m][1];
                    u32x4 w; w.x = pk2(o[0] + g[0] * v0[0], o[1] + g[1] * v0[1]); w.y = pk2(o[2] + g[2] * v0[2], o[3] + g[3] * v0[3]);
                    w.z = pk2(o[4] + g[4] * v1[0], o[5] + g[5] * v1[1]); w.w = pk2(o[6] + g[6] * v1[2], o[7] + g[7] * v1[3]);
                    if (br < 3) *(u32x4*)(ps + ((((size_t)(u.pm * 4 + (u.pn & 3)) * 8 + wr * 4 + wc) * 16 + (ai * 8 + m * 2 + bj)) * 64 + fq * 16 + fr) * 8) = w;
                    else *(u32x4*)(mb + r * DM + col0 + bj * 128) = w; }
            asm volatile("" ::: "memory");
        }
    }
};
struct EpiOut {
    static constexpr bool PERM = true, AFTER_DRAIN = false;
    const float* xin; const float* xcin; float* xout; float* xcout; const float* mod;
    __device__ __forceinline__ void operator()(const f32x4 (&acc)[2][2][4][2], const pg8::Unit& u, int wr, int wc, int fr, int fq) const {
        const int pm = u.pm; const bool isctx = pm >= 64;
        const float* gate = mod + (isctx ? 8 : (pm >> 3)) * 3072 + 2048;
        const float* src = isctx ? xcin : xin; float* dst = isctx ? xcout : xout;
        const int row0 = (isctx ? (pm - 64) : pm) * 256 + wr * 64 + fr; const int col0 = u.pn * 256 + wc * 32 + 8 * fq;
#pragma unroll
        for (int bj = 0; bj < 2; ++bj)
#pragma unroll
            for (int ai = 0; ai < 2; ++ai) {
                const int c = col0 + bj * 128; const f32x4 gv0 = *(const f32x4*)(gate + c), gv1 = *(const f32x4*)(gate + c + 4);
                f32x4 xq[4][2];
#pragma unroll
                for (int m = 0; m < 4; ++m) { const float* p = src + (size_t)(row0 + ai * 128 + m * 16) * DM + c; xq[m][0] = *(const f32x4*)p; xq[m][1] = *(const f32x4*)(p + 4); }
#pragma unroll
                for (int m = 0; m < 4; ++m) { float* p = dst + (size_t)(row0 + ai * 128 + m * 16) * DM + c; *(f32x4*)p = xq[m][0] + gv0 * acc[ai][bj][m][0]; *(f32x4*)(p + 4) = xq[m][1] + gv1 * acc[ai][bj][m][1]; }
                asm volatile("" ::: "memory");
            }
    }
};

__device__ __forceinline__ void transpose_item(const float* W, int K, int N, bf16_t* WT, int k0, int n0, int drow0, LAS float* scr, int lane, bool hp = false) {
#pragma unroll 8
    for (int i = 0; i < 32; ++i) { const int kk = 2 * i + (lane >> 5); scr[kk * 33 + (lane & 31)] = W[(size_t)(k0 + kk) * N + n0 + (lane & 31)]; }
    LDS_WAIT();
    const int c = lane & 7;
#pragma unroll
    for (int j = 0; j < 4; ++j) { const int n = (lane >> 3) + 8 * j; const LAS float* s = scr + (8 * c) * 33 + n;
        u32x4 o; o.x = pk2(s[0 * 33], s[1 * 33]); o.y = pk2(s[2 * 33], s[3 * 33]); o.z = pk2(s[4 * 33], s[5 * 33]); o.w = pk2(s[6 * 33], s[7 * 33]);
        const int dn = hp ? (128 * (n >> 4) + (n & 15)) : n;
        *(u32x4*)(WT + (size_t)(drow0 + dn) * K + k0 + 8 * c) = o; }
    LDS_WAIT();
}
__device__ __forceinline__ void convert_weights(KA a, int l, lds_t* lds, int gw, int ngw, int wid, int lane, int item0, int it_lo, int it_hi) {
    LAS float* scr = (LAS float*)(lds + wid * 8704);
    bf16_t* WinT = (bf16_t*)(a->ws + WS_W); bf16_t* WbrT = (bf16_t*)(a->ws + WS_WBR); bf16_t* WoT = (bf16_t*)(a->ws + WS_WO);
    for (int it = it_lo + gw - item0; it < it_hi; it += ngw) {
        if (it < it_lo) continue;
        int r = it;
        if (r < 5504) { const int kb = r / 344, nb = r % 344; const int n0 = nb * 32; int d0 = n0; bool hp = false;
            if (n0 < 512) d0 = (n0 >> 7) * 256 + (n0 & 127); else if (n0 < 1024) d0 = ((n0 - 512) >> 7) * 256 + 128 + (n0 & 127);
            else if ((n0 >= 1536 && n0 < 2560) || (n0 >= 3584 && n0 < 4352) || (n0 >= 4864 && n0 < 5888)) {
                const int sc = n0 & 255; d0 = (n0 & ~255) + 32 * (sc >> 6) + 16 * ((sc >> 5) & 1); hp = true; }
            transpose_item(a->in[7] + (size_t)l * DM * INW, DM, INW, WinT, kb * 64, n0, d0, scr, lane, hp); continue; }
        r -= 5504;
        if (r < 1024) { const int br = r >> 8, rr = r & 255; transpose_item(a->in[25 + br] + (size_t)l * 512 * DM, 512, DM, WbrT + (size_t)br * DM * 512, (rr >> 5) * 64, (rr & 31) * 32, (rr & 31) * 32, scr, lane); continue; }
        r -= 1024;
        transpose_item(a->in[29] + (size_t)l * DM * DM, DM, DM, WoT, (r >> 5) * 64, (r & 31) * 32, (r & 31) * 32, scr, lane);
    }
}

__device__ __forceinline__ void norm_phase(const float* xin, const float* xcin, const float* g, const float* mod, bf16_t* hn, int gw, int ngw, int lane) {
    f32x4 v[4], vn[4];
    { const int row = gw; if (row < NTOK) { const float* xr = row >= NLAT ? xcin + (size_t)(row - NLAT) * DM : xin + (size_t)row * DM;
#pragma unroll
        for (int j = 0; j < 4; ++j) v[j] = ((const f32x4*)xr)[lane + 64 * j]; } }
    for (int row = gw; row < NTOK; row += ngw) {
        const bool isctx = row >= NLAT;
        const float* mb = mod + (isctx ? 8 : row / SEQ) * 3072;
        f32x4 gg[4], sh[4], sc[4];
#pragma unroll
        for (int j = 0; j < 4; ++j) { const int c = 4 * (lane + 64 * j); gg[j] = *(const f32x4*)(g + c); sh[j] = *(const f32x4*)(mb + c); sc[j] = *(const f32x4*)(mb + 1024 + c); }
        const int nrow = row + ngw;
        if (nrow < NTOK) { const float* xr = nrow >= NLAT ? xcin + (size_t)(nrow - NLAT) * DM : xin + (size_t)nrow * DM;
#pragma unroll
            for (int j = 0; j < 4; ++j) vn[j] = ((const f32x4*)xr)[lane + 64 * j]; }
        float ss = 0.f;
#pragma unroll
        for (int j = 0; j < 4; ++j) ss += (v[j].x * v[j].x + v[j].y * v[j].y) + (v[j].z * v[j].z + v[j].w * v[j].w);
        const float rstd = rsqrtf(wave_sum(ss) * (1.f / DM) + EPSN);
#pragma unroll
        for (int j = 0; j < 4; ++j) { const int c = 4 * (lane + 64 * j);
            const f32x4 y = v[j] * rstd * gg[j] * (sc[j] + 1.f) + sh[j];
            u32x2 o; o.x = pk2(y.x, y.y); o.y = pk2(y.z, y.w);
            *(u32x2*)(hn + (size_t)row * DM + c) = o; }
#pragma unroll
        for (int j = 0; j < 4; ++j) v[j] = vn[j];
    }
}

__device__ __forceinline__ void prep_phase(KA a, int l, lds_t* lds, int gw, int ngw, int wid, int lane, bool dry) {
    bf16_t* qkv = (bf16_t*)(a->ws + WS_QKV); bf16_t* vt = (bf16_t*)(a->ws + WS_VT);
    const float* rope = (const float*)(a->ws + WS_ROPE);
    const int j = lane & 7;
    for (int row = gw; row < NTOK; row += ngw) {
        const bool isctx = row >= NLAT; const int t = row & (SEQ - 1);
        bf16_t* rp = qkv + (size_t)row * QP;
        u32x4 raws[6];
#pragma unroll
        for (int it = 0; it < 6; ++it) { const int vr = it * 8 + (lane >> 3); const int v = vr < 42 ? vr : 41;
            const int col = v < 16 ? 512 + 64 * v : (v < 26 ? 2048 + 64 * (v - 16) : 2816 + 64 * (v - 26));
            raws[it] = *(const u32x4*)(rp + col + j * 8); }
#pragma unroll
        for (int it = 0; it < 6; ++it) {
            const int vr = it * 8 + (lane >> 3); const bool valid = vr < 42; const int v = valid ? vr : 41;
            const int col = v < 16 ? 512 + 64 * v : (v < 26 ? 2048 + 64 * (v - 16) : 2816 + 64 * (v - 26));
            const int gi = v < 8 ? 13 : (v < 16 ? 14 : (v < 24 ? 16 : (v < 26 ? 17 : (v < 34 ? 18 : 19))));
            const bool isq = (v < 8) || (v >= 16 && v < 24) || (v >= 26 && v < 34);
            const bool dorope = (v >= 16) && !isctx;
            const float* gp = a->in[gi] + l * 64 + j * 8;
            const u32x4 raw = raws[it];
            float x[8]; unpack8(raw, x);
            float ss = 0.f;
#pragma unroll
            for (int e = 0; e < 8; ++e) ss += x[e] * x[e];
            ss += __shfl_xor(ss, 1); ss += __shfl_xor(ss, 2); ss += __shfl_xor(ss, 4);
            const float rstd = rsqrtf(ss * (1.f / 64.f) + EPSN);
            const f32x4 g0 = *(const f32x4*)gp, g1 = *(const f32x4*)(gp + 4);
            float y[8] = {x[0] * rstd * g0.x, x[1] * rstd * g0.y, x[2] * rstd * g0.z, x[3] * rstd * g0.w, x[4] * rstd * g1.x, x[5] * rstd * g1.y, x[6] * rstd * g1.z, x[7] * rstd * g1.w};
            const int pos = (j < 4) ? (t >> 6) : (t & 63);
            const float* cp = rope + pos * 16 + 8 * (j & 1);
            const float sgn = (j & 2) ? 1.f : -1.f;
#pragma unroll
            for (int e = 0; e < 8; ++e) { const float p = __shfl_xor(y[e], 2); if (dorope) y[e] = y[e] * cp[e] + sgn * p * cp[1024 + e]; }
            const float qs = isq ? C2 : 1.f;
            u32x4 o; o.x = pk2(y[0] * qs, y[1] * qs); o.y = pk2(y[2] * qs, y[3] * qs); o.z = pk2(y[4] * qs, y[5] * qs); o.w = pk2(y[6] * qs, y[7] * qs);
            if (valid && !dry) *(u32x4*)(rp + col + j * 8) = o;
        }
    }
}

struct AttnP {
    const bf16_t* qkv; bf16_t* y; int vcol;
    int qrow, qcol, kcol, kcoff, ntile, nlat, lat_row0, lat_key0, ctx_row0, ycol;
    int qgr, kgr0, qc0; const float* rpb;
    float lam, oml; const float* subg;
};
__device__ __forceinline__ int crow(int r, int hi) { return (r & 3) + 8 * (r >> 2) + 4 * hi; }
constexpr int AT_VS0 = 34816, AT_WSF = 90112, AT_BIAS = 91136, AT_EO = 93184;

__device__ __forceinline__ float max3f(float a, float b, float c) { float r; asm("v_max3_f32 %0, %1, %2, %3" : "=v"(r) : "v"(a), "v"(b), "v"(c)); return r; }
constexpr float AT_THR = 6.0f;
template <int KW, int DV, int MODE, int VAR>
__device__ __forceinline__ void attn_tile(lds_t* lds, const AttnP& P, int t, int st, int l32, int hi, LAS float* wsf, const LAS float* biasl,
                                          const bf16x8 (&qf)[4], const unsigned (&bpk)[16], f32x16 (&O)[DV / 32], f32x16& negm, float& mrun, float& lrun) {
    constexpr int KP = KW * 2 + 16, VP = (DV == 64) ? 192 : 320, KSB = 64 * KP, VSB = 64 * VP, NDB = DV / 32;
    typedef float f32x2 __attribute__((ext_vector_type(2)));
    bool active = true; int dr = 0;
    if (MODE == 1 && t < P.nlat) { const int kr = P.kgr0 + t; int r0 = P.qgr - 4; r0 = r0 < 0 ? 0 : (r0 > 24 ? 24 : r0); active = (kr >= r0) && (kr < r0 + 8); dr = kr - P.qgr + 7; }
    if (!active) return;
    constexpr bool VHOIST = (MODE != 2) && (VAR != 2);
    typedef short v4i16h_t __attribute__((ext_vector_type(4)));
    bf16x8 vh[2][4];
    if (VHOIST) {
        const lds_t* vb0 = lds + AT_VS0 + st * (64 * ((DV == 64) ? 192 : 320)) + (4 * hi + ((l32 & 15) >> 2)) * ((DV == 64) ? 192 : 320) + (16 * (l32 >> 4) + 4 * (l32 & 3)) * 2;
#pragma unroll
        for (int d2 = 0; d2 < 2; ++d2)
#pragma unroll
            for (int kj = 0; kj < 4; ++kj) {
                const lds_t* ap = vb0 + kj * 16 * ((DV == 64) ? 192 : 320) + d2 * 64;
                const s16x4 lo = __builtin_bit_cast(s16x4, __builtin_amdgcn_ds_read_tr16_b64_v4i16((LAS v4i16h_t*)ap));
                const s16x4 hh = __builtin_bit_cast(s16x4, __builtin_amdgcn_ds_read_tr16_b64_v4i16((LAS v4i16h_t*)(ap + 8 * ((DV == 64) ? 192 : 320))));
                vh[d2][kj] = (bf16x8){lo[0], lo[1], lo[2], lo[3], hh[0], hh[1], hh[2], hh[3]};
            }
    }
    const lds_t* kb_ = lds + st * KSB + l32 * KP + P.kcoff * 2 + hi * 16;
    f32x16 s0, s1;
    if (VAR == 3) {
#pragma unroll
        for (int r = 0; r < 16; ++r) { s0[r] = (float)(t + r) * 1e-3f; s1[r] = (float)(t - r) * 1e-3f; }
    } else {
        bf16x8 kf[8];
#pragma unroll
        for (int d = 0; d < 4; ++d) { kf[2 * d] = *(const LAS bf16x8*)(kb_ + d * 32); kf[2 * d + 1] = *(const LAS bf16x8*)(kb_ + 32 * KP + d * 32); }
        asm volatile("" ::: "memory");
        __builtin_amdgcn_s_setprio(1);
#pragma unroll
        for (int d = 0; d < 4; ++d) {
            if (d == 0) { s0 = __builtin_amdgcn_mfma_f32_32x32x16_bf16(kf[0], qf[0], negm, 0, 0, 0); s1 = __builtin_amdgcn_mfma_f32_32x32x16_bf16(kf[1], qf[0], negm, 0, 0, 0); }
            else { s0 = __builtin_amdgcn_mfma_f32_32x32x16_bf16(kf[2 * d], qf[d], s0, 0, 0, 0); s1 = __builtin_amdgcn_mfma_f32_32x32x16_bf16(kf[2 * d + 1], qf[d], s1, 0, 0, 0); }
        }
        __builtin_amdgcn_s_setprio(0);
    }
    if (MODE == 1 && t < P.nlat) {
        const LAS unsigned char* brow = (const LAS unsigned char*)(biasl + dr * 32);
#pragma unroll
        for (int r = 0; r < 16; ++r) { s0[r] += *(const LAS float*)(brow + (bpk[r] & 0xffffu)); s1[r] += *(const LAS float*)(brow + (bpk[r] >> 16)); }
    }
    if (VAR != 1) {
        float ma = max3f(s0[0], s0[1], s0[2]), mb = max3f(s0[3], s0[4], s0[5]), mc = max3f(s1[0], s1[1], s1[2]), md = max3f(s1[3], s1[4], s1[5]);
        ma = max3f(ma, s0[6], s0[7]); mb = max3f(mb, s0[8], s0[9]); ma = max3f(ma, s0[10], s0[11]); mb = max3f(mb, s0[12], s0[13]); ma = max3f(ma, s0[14], s0[15]);
        mc = max3f(mc, s1[6], s1[7]); md = max3f(md, s1[8], s1[9]); mc = max3f(mc, s1[10], s1[11]); md = max3f(md, s1[12], s1[13]); mc = max3f(mc, s1[14], s1[15]);
        float mx = max3f(ma, mb, mc); mx = fmaxf(mx, md);
        mx = fmaxf(mx, __shfl_xor(mx, 32));
        const bool fresh = (lrun == 0.f);
        if (__any(fresh || mx > AT_THR)) {
            const float dl = fresh ? mx : fmaxf(mx, 0.f);
            const float alpha = fresh ? 1.f : fexp2(-dl);
            mrun += dl; lrun *= alpha;
#pragma unroll
            for (int r = 0; r < 16; ++r) { s0[r] -= dl; s1[r] -= dl; negm[r] = -mrun; }
            if (hi == 0) wsf[l32] = alpha;
            LDS_WAIT();
            float av[16];
#pragma unroll
            for (int j = 0; j < 4; ++j) { const f32x4 a4 = *(const LAS f32x4*)(wsf + 8 * j + 4 * hi); av[4 * j] = a4.x; av[4 * j + 1] = a4.y; av[4 * j + 2] = a4.z; av[4 * j + 3] = a4.w; }
#pragma unroll
            for (int db = 0; db < NDB; ++db)
#pragma unroll
                for (int r = 0; r < 16; ++r) O[db][r] *= av[r];
            LDS_WAIT();
        }
#pragma unroll
        for (int r = 0; r < 16; ++r) { s0[r] = fexp2(s0[r]); s1[r] = fexp2(s1[r]); }
    }
    f32x2 lsa = {s0[0], s1[0]}, lsb = {s0[1], s1[1]}, lsc = {s0[2], s1[2]}, lsd = {s0[3], s1[3]};
#pragma unroll
    for (int r = 4; r < 16; r += 4) { lsa += (f32x2){s0[r], s1[r]}; lsb += (f32x2){s0[r + 1], s1[r + 1]}; lsc += (f32x2){s0[r + 2], s1[r + 2]}; lsd += (f32x2){s0[r + 3], s1[r + 3]}; }
    lsa += lsb; lsc += lsd; lsa += lsc;
    lrun += lsa.x + lsa.y;
    bf16x8 pa[4];
#pragma unroll
    for (int jj = 0; jj < 2; ++jj) {
        u32x4 w0, w1;
        w0.x = pk2(s0[8 * jj + 0], s0[8 * jj + 1]); w0.y = pk2(s0[8 * jj + 2], s0[8 * jj + 3]); w0.z = pk2(s0[8 * jj + 4], s0[8 * jj + 5]); w0.w = pk2(s0[8 * jj + 6], s0[8 * jj + 7]);
        w1.x = pk2(s1[8 * jj + 0], s1[8 * jj + 1]); w1.y = pk2(s1[8 * jj + 2], s1[8 * jj + 3]); w1.z = pk2(s1[8 * jj + 4], s1[8 * jj + 5]); w1.w = pk2(s1[8 * jj + 6], s1[8 * jj + 7]);
        pa[jj] = __builtin_bit_cast(bf16x8, w0); pa[2 + jj] = __builtin_bit_cast(bf16x8, w1);
    }
    const lds_t* vb_ = lds + AT_VS0 + st * VSB + (4 * hi + ((l32 & 15) >> 2)) * VP + (16 * (l32 >> 4) + 4 * (l32 & 3)) * 2;
#pragma unroll
    for (int dh = 0; dh < NDB; dh += 2) {
        typedef short v4i16_t __attribute__((ext_vector_type(4)));
        bf16x8 vfr[2][4];
        if (VHOIST) {
#pragma unroll
            for (int d2 = 0; d2 < 2; ++d2)
#pragma unroll
                for (int kj = 0; kj < 4; ++kj) vfr[d2][kj] = vh[d2][kj];
        } else if (VAR != 2) {
#pragma unroll
            for (int d2 = 0; d2 < 2; ++d2)
#pragma unroll
                for (int kj = 0; kj < 4; ++kj) {
                    const lds_t* ap = vb_ + kj * 16 * VP + (dh + d2) * 64;
                    const s16x4 lo = __builtin_bit_cast(s16x4, __builtin_amdgcn_ds_read_tr16_b64_v4i16((LAS v4i16_t*)ap));
                    const s16x4 hh = __builtin_bit_cast(s16x4, __builtin_amdgcn_ds_read_tr16_b64_v4i16((LAS v4i16_t*)(ap + 8 * VP)));
                    vfr[d2][kj] = (bf16x8){lo[0], lo[1], lo[2], lo[3], hh[0], hh[1], hh[2], hh[3]};
                }
            asm volatile("" ::: "memory");
        }
#pragma unroll
        for (int kj = 0; kj < 4; ++kj)
#pragma unroll
            for (int d2 = 0; d2 < 2; ++d2) {
                const int db = dh + d2;
                if (VAR == 2) { O[db][kj] += (float)pa[kj][0] + (float)pa[kj][1] + (float)pa[kj][2] + (float)pa[kj][3] + (float)pa[kj][4] + (float)pa[kj][5] + (float)pa[kj][6] + (float)pa[kj][7]; continue; }
                O[db] = __builtin_amdgcn_mfma_f32_32x32x16_bf16(pa[kj], vfr[d2][kj], O[db], 0, 0, 0);
            }
    }
}

template <int KW, int DV, int MODE, int VAR>
__device__ __forceinline__ void attn_unit(lds_t* lds, const AttnP& P, bool dry) {
    constexpr int KP = KW * 2 + 16, VP = (DV == 64) ? 192 : 320, KSB = 64 * KP, VSB = 64 * VP, NDB = DV / 32, NKR = KW / 64, NVR = DV / 64;
    const int tid = opaque_tid(), lane = tid & 63, wid = __builtin_amdgcn_readfirstlane(tid >> 6), l32 = lane & 31, hi = lane >> 5;
    LAS float* wsf = (LAS float*)(lds + AT_WSF) + wid * 32;
    LAS float* biasl = (LAS float*)(lds + AT_BIAS);
    unsigned bpk[16];
#pragma unroll
    for (int r = 0; r < 16; ++r) bpk[r] = 0u;
    if (MODE == 1) {
        for (int i = tid; i < 15 * 32; i += 512) { const int d = i >> 5, c = i & 31; biasl[i] = (c < 31) ? P.rpb[d * 31 + c] * LOG2E : -1e30f; }
        const int qc = P.qc0 + l32; int c0 = qc - 8; c0 = c0 < 0 ? 0 : (c0 > 48 ? 48 : c0);
#pragma unroll
        for (int r = 0; r < 16; ++r) { const int kc0 = crow(r, hi), kc1 = 32 + kc0;
            const unsigned i0 = ((unsigned)(kc0 - c0) < 16u) ? (unsigned)(kc0 - qc + 15) : 31u, i1 = ((unsigned)(kc1 - c0) < 16u) ? (unsigned)(kc1 - qc + 15) : 31u;
            bpk[r] = (i0 * 4u) | ((i1 * 4u) << 16); }
    }
    bf16x8 qf[4];
    { const bf16_t* qp = P.qkv + (size_t)(P.qrow + l32) * QP + P.qcol + hi * 8;
#pragma unroll
      for (int d = 0; d < 4; ++d) qf[d] = *(const bf16x8*)(qp + d * 16); }
    f32x16 O[NDB];
#pragma unroll
    for (int db = 0; db < NDB; ++db)
#pragma unroll
        for (int r = 0; r < 16; ++r) O[db][r] = 0.f;
    float mrun = 0.f, lrun = 0.f;
    f32x16 negm;
#pragma unroll
    for (int r = 0; r < 16; ++r) negm[r] = 0.f;
    u32x4 kA[NKR], vA[NVR], kB[NKR], vB[NVR];
    const int nt = (VAR == 6) ? 1 : P.ntile;
#define AT_LOAD(t_, kreg, vreg) do { const int t__ = (t_); const int krow_ = t__ < P.nlat ? P.lat_row0 + 64 * t__ : P.ctx_row0 + 64 * (t__ - P.nlat); const int vkey_ = t__ < P.nlat ? P.lat_key0 + 64 * t__ : SEQ + 64 * (t__ - P.nlat); \
        _Pragma("unroll") for (int i_ = 0; i_ < NKR; ++i_) { const int c_ = tid + 512 * i_; const int r_ = c_ / (KW / 8), ch_ = c_ % (KW / 8); kreg[i_] = *(const u32x4*)(P.qkv + (size_t)(krow_ + r_) * QP + P.kcol + ch_ * 8); } \
        _Pragma("unroll") for (int i_ = 0; i_ < NVR; ++i_) { const int c_ = tid + 512 * i_; const int r_ = c_ / (DV / 8), ch_ = c_ % (DV / 8); vreg[i_] = *(const u32x4*)(P.qkv + (size_t)(krow_ + r_) * QP + P.vcol + ch_ * 8); } } while (0)
#define AT_STORE(st_, kreg, vreg) do { \
        _Pragma("unroll") for (int i_ = 0; i_ < NKR; ++i_) { const int c_ = tid + 512 * i_; const int r_ = c_ / (KW / 8), ch_ = c_ % (KW / 8); *(LAS u32x4*)(lds + (st_) * KSB + r_ * KP + ch_ * 16) = kreg[i_]; } \
        _Pragma("unroll") for (int i_ = 0; i_ < NVR; ++i_) { const int c_ = tid + 512 * i_; const int r_ = c_ / (DV / 8), ch_ = c_ % (DV / 8); *(LAS u32x4*)(lds + AT_VS0 + (st_) * VSB + r_ * VP + ch_ * 16) = vreg[i_]; } } while (0)
#define AT_BAR0() asm volatile("s_waitcnt lgkmcnt(0)\n\ts_barrier" ::: "memory")
#define AT_BAR() do { if (VAR != 5) AT_BAR0(); } while (0)
    AT_LOAD(0, kA, vA); AT_STORE(0, kA, vA);
    if (nt > 1) AT_LOAD(1, kB, vB);
    AT_BAR0();
    for (int t = 0; t < nt; t += 2) {
        if (VAR != 4 && t + 2 < nt) AT_LOAD(t + 2, kA, vA);
        attn_tile<KW, DV, MODE, VAR>(lds, P, t, 0, l32, hi, wsf, biasl, qf, bpk, O, negm, mrun, lrun);
        if (t + 1 < nt) AT_STORE(1, kB, vB);
        AT_BAR();
        if (t + 1 < nt) {
            if (VAR != 4 && t + 3 < nt) AT_LOAD(t + 3, kB, vB);
            attn_tile<KW, DV, MODE, VAR>(lds, P, t + 1, 1, l32, hi, wsf, biasl, qf, bpk, O, negm, mrun, lrun);
            if (t + 2 < nt) AT_STORE(0, kA, vA);
            AT_BAR();
        }
    }
    if (VAR == 5) asm volatile("s_waitcnt lgkmcnt(0)\n\ts_barrier" ::: "memory");
#undef AT_LOAD
#undef AT_STORE
#undef AT_BAR
#undef AT_BAR0
    const float lt = lrun + __shfl_xor(lrun, 32);
    if (hi == 0) wsf[l32] = 1.f / lt;
    LDS_WAIT();
    float av[16];
#pragma unroll
    for (int j = 0; j < 4; ++j) { const f32x4 a4 = *(const LAS f32x4*)(wsf + 8 * j + 4 * hi); av[4 * j] = a4.x; av[4 * j + 1] = a4.y; av[4 * j + 2] = a4.z; av[4 * j + 3] = a4.w; }
    LDS_WAIT();
    if (MODE != 2) {
        static_assert(MODE == 2 || DV == 64, "row-staged epilogue is written for 64-wide heads");
        lds_t* eo = lds + AT_EO + wid * 4608;
        u32x4 gq[4];
#pragma unroll
        for (int i = 0; i < 4; ++i) { const int c = lane + 64 * i; gq[i] = *(const u32x4*)(P.y + (size_t)(P.qrow + (c >> 3)) * YP + P.ycol + (c & 7) * 8); }
#pragma unroll
        for (int db = 0; db < NDB; ++db)
#pragma unroll
            for (int r = 0; r < 16; ++r) *(LAS bf16_t*)(eo + crow(r, hi) * 144 + (db * 32 + l32) * 2) = (bf16_t)f2bf(O[db][r] * av[r]);
        LDS_WAIT();
#pragma unroll
        for (int i = 0; i < 4; ++i) { const int c = lane + 64 * i;
            const u32x4 ow = *(const LAS u32x4*)(eo + (c >> 3) * 144 + (c & 7) * 16);
            float o[8], g[8]; unpack8(ow, o); unpack8(gq[i], g);
            u32x4 w; w.x = pk2(o[0] * silu(g[0]), o[1] * silu(g[1])); w.y = pk2(o[2] * silu(g[2]), o[3] * silu(g[3])); w.z = pk2(o[4] * silu(g[4]), o[5] * silu(g[5])); w.w = pk2(o[6] * silu(g[6]), o[7] * silu(g[7]));
            if (!dry) *(u32x4*)(P.y + (size_t)(P.qrow + (c >> 3)) * YP + P.ycol + (c & 7) * 8) = w; }
        LDS_WAIT();
    } else {
        LAS float* X = (LAS float*)lds;
        const int qs = 32 * (wid & 3);
        if (wid >= 4) {
#pragma unroll
            for (int db = 0; db < NDB; ++db)
#pragma unroll
                for (int r = 0; r < 16; ++r) X[(qs + crow(r, hi)) * 132 + db * 32 + l32] = O[db][r] * av[r];
        }
        __syncthreads();
        if (wid < 4) {
            lds_t* eo = lds + AT_EO + wid * 8704;
            u32x4 gq[8];
#pragma unroll
            for (int i = 0; i < 8; ++i) { const int c = lane + 64 * i; gq[i] = *(const u32x4*)(P.y + (size_t)(P.qrow + (c >> 4)) * YP + P.ycol + (c & 15) * 8); }
            float ssq[16];
#pragma unroll
            for (int r = 0; r < 16; ++r) ssq[r] = 0.f;
#pragma unroll
            for (int db = 0; db < NDB; ++db)
#pragma unroll
                for (int r = 0; r < 16; ++r) { const float o = O[db][r] * av[r] - P.lam * X[(qs + crow(r, hi)) * 132 + db * 32 + l32]; O[db][r] = o; ssq[r] += o * o; }
#pragma unroll
            for (int r = 0; r < 16; ++r) { float s = ssq[r]; s += __shfl_xor(s, 1); s += __shfl_xor(s, 2); s += __shfl_xor(s, 4); s += __shfl_xor(s, 8); s += __shfl_xor(s, 16); ssq[r] = rsqrtf(s * (1.f / 128.f) + EPSN) * P.oml; }
#pragma unroll
            for (int db = 0; db < NDB; ++db) {
                const float sg = P.subg[db * 32 + l32];
#pragma unroll
                for (int r = 0; r < 16; ++r) *(LAS bf16_t*)(eo + crow(r, hi) * 272 + (db * 32 + l32) * 2) = (bf16_t)f2bf(O[db][r] * ssq[r] * sg);
            }
            LDS_WAIT();
#pragma unroll
            for (int i = 0; i < 8; ++i) { const int c = lane + 64 * i;
                const u32x4 ow = *(const LAS u32x4*)(eo + (c >> 4) * 272 + (c & 15) * 16);
                float o[8], g[8]; unpack8(ow, o); unpack8(gq[i], g);
                u32x4 w; w.x = pk2(o[0] * silu(g[0]), o[1] * silu(g[1])); w.y = pk2(o[2] * silu(g[2]), o[3] * silu(g[3])); w.z = pk2(o[4] * silu(g[4]), o[5] * silu(g[5])); w.w = pk2(o[6] * silu(g[6]), o[7] * silu(g[7]));
                if (!dry) *(u32x4*)(P.y + (size_t)(P.qrow + (c >> 4)) * YP + P.ycol + (c & 15) * 8) = w; }
            LDS_WAIT();
        }
        __syncthreads();
    }
}

__device__ __forceinline__ void conv_unit(lds_t* lds, KA a, int l, int row0, int seqlen, int t0, bool dry) {
    const int tid = opaque_tid(), lane = tid & 63, wid = tid >> 6, c = tid;
    const bf16_t* qkv = (const bf16_t*)(a->ws + WS_QKV); bf16_t* Y = (bf16_t*)(a->ws + WS_Y);
#pragma unroll
    for (int i = 0; i < 8; ++i) { const int idx = tid + 512 * i;
        if (idx < 62 * 64) { const int r = idx >> 6, ch = idx & 63; const int tt = t0 - 15 + r;
            u32x4 v = {0u, 0u, 0u, 0u};
            if (tt >= 0 && tt < seqlen) v = *(const u32x4*)(qkv + (size_t)(row0 + tt) * QP + ch * 8);
            *(LAS u32x4*)(lds + r * 1024 + ch * 16) = v; } }
    float w[31];
#pragma unroll
    for (int k = 0; k < 31; ++k) w[k] = a->in[9][(size_t)(l * 31 + k) * 512 + c];
    const float cb = a->in[10][l * 512 + c], lg = a->in[11][l * 512 + c], lb = a->in[12][l * 512 + c];
    __syncthreads();
    float hv[62];
#pragma unroll
    for (int r = 0; r < 62; ++r) hv[r] = bf2f(*(const LAS bf16_t*)(lds + r * 1024 + c * 2));
    float v[32];
#pragma unroll
    for (int t = 0; t < 32; ++t) { float acc = cb;
#pragma unroll
        for (int k = 0; k < 31; ++k) acc += w[k] * hv[t + k];
        v[t] = acc; }
    __syncthreads();
    LAS float* vb = (LAS float*)lds; LAS float* stats = (LAS float*)(lds + 65536);
#pragma unroll
    for (int t = 0; t < 32; ++t) vb[t * 512 + c] = v[t];
    __syncthreads();
#pragma unroll
    for (int q = 0; q < 4; ++q) { const int t = wid * 4 + q; float xs[8]; float s = 0.f;
#pragma unroll
        for (int i = 0; i < 8; ++i) { xs[i] = vb[t * 512 + lane + 64 * i]; s += xs[i]; }
        const float mean = wave_sum(s) * (1.f / 512.f); float q2 = 0.f;
#pragma unroll
        for (int i = 0; i < 8; ++i) { const float d = xs[i] - mean; q2 += d * d; }
        const float rstd = rsqrtf(wave_sum(q2) * (1.f / 512.f) + EPSN);
        if (lane == 0) { stats[2 * t] = mean; stats[2 * t + 1] = rstd; } }
    __syncthreads();
    bf16_t gtc[32];
#pragma unroll
    for (int t = 0; t < 32; ++t) gtc[t] = Y[(size_t)(row0 + t0 + t) * YP + c];
#pragma unroll
    for (int t = 0; t < 32; ++t) {
        const float yn = (v[t] - stats[2 * t]) * stats[2 * t + 1] * lg + lb;
        bf16_t* yp = Y + (size_t)(row0 + t0 + t) * YP + c;
        const float g = bf2f(gtc[t]);
        if (!dry) *yp = (bf16_t)f2bf(silu(yn) * silu(g));
    }
    __syncthreads();
}

template <int KM, int VAR> __device__ __forceinline__ void mix_phase(lds_t* lds, KA a, int l, bool dry) {
    const int wid = __builtin_amdgcn_readfirstlane(opaque_tid() >> 6);
    const int nunit = (l == 0) ? 2304 : 2048;
    const float lam_init = (l == 0) ? 0.2f : (0.8f - 0.6f * 0.7408182206817179f);
    AttnP P; P.qkv = (const bf16_t*)(a->ws + WS_QKV); P.y = (bf16_t*)(a->ws + WS_Y);
    P.lam = ((const float*)(a->ws + WS_LAM))[l]; P.oml = 1.f - lam_init; P.subg = a->in[24] + l * 128;
    P.qgr = 0; P.kgr0 = 0; P.qc0 = 0; P.rpb = a->in[15]; P.kcoff = 0;
    const bool remap = gridDim.x == 256; const int xcd = blockIdx.x & 7, slot = blockIdx.x >> 3;
    for (int ui = blockIdx.x; ui < nunit; ui += gridDim.x) {
        int kind, cv_row0 = 0, cv_len = SEQ, cv_t0 = 0;
        P.kcoff = 0; P.nlat = 32; P.ntile = 36; P.lat_key0 = 0;
        if (ui < 512 || (ui >= 2112 && ui < 2176)) {
            const bool cx = ui >= 512; const int u = cx ? ui - 2112 : (remap ? (((ui >> 8) * 16 + 2 * xcd + (slot >> 4)) * 16 + (slot & 15)) : ui);
            const int b = cx ? (u >> 3) : (u >> 6), h = cx ? ((u >> 1) & 3) : ((u >> 4) & 3), qb = cx ? (u & 1) : (u & 15), t = wid >> 2;
            kind = 2;
            P.qrow = (cx ? NLAT + b * CTXL : b * SEQ) + qb * 128 + 32 * (wid & 3); P.qcol = 2816 + (2 * h + t) * 64; P.kcol = 3328 + 128 * h; P.kcoff = 64 * t;
            P.vcol = 3840 + 128 * h; P.lat_row0 = b * SEQ; P.ctx_row0 = NLAT + b * CTXL; P.ycol = 1536 + 128 * h;
            if (cx) { P.nlat = 0; P.ntile = 4; }
        } else if (ui < 1024) {
            const int u = remap ? ((((ui - 512) >> 8) * 8 + xcd) * 32 + slot) : ui - 512; const int b = u >> 6, n = (u >> 5) & 1, qb = u & 31, hq = 4 * n + (wid >> 1);
            kind = 0;
            P.qrow = b * SEQ + qb * 64 + 32 * (wid & 1); P.qcol = 2048 + 64 * hq; P.kcol = 2560 + 64 * n;
            P.vcol = 2688 + 64 * n; P.lat_row0 = b * SEQ; P.ctx_row0 = NLAT + b * CTXL; P.ycol = 1024 + 64 * hq;
        } else if (ui < 1536) {
            const int u = remap ? ((((ui - 1024) >> 8) * 32 + 4 * xcd + (slot >> 3)) * 8 + ((slot + 4 * ((ui - 1024) >> 8)) & 7)) : ui - 1024; const int b = u >> 6, h = (u >> 3) & 7, rg = u & 7;
            int k0 = 4 * rg - 4; k0 = k0 < 0 ? 0 : (k0 > 24 ? 24 : k0); int k1 = 4 * rg + 3 - 4; k1 = k1 < 0 ? 0 : (k1 > 24 ? 24 : k1);
            kind = 1;
            P.qgr = 4 * rg + (wid >> 1); P.qc0 = 32 * (wid & 1); P.kgr0 = k0; P.rpb = a->in[15] + (size_t)(l * 8 + h) * 465;
            P.qrow = b * SEQ + P.qgr * 64 + P.qc0; P.qcol = 512 + 64 * h; P.kcol = 1024 + 64 * h;
            P.vcol = 1536 + 64 * h; P.nlat = k1 + 8 - k0; P.ntile = P.nlat + 4; P.lat_row0 = b * SEQ + k0 * 64; P.lat_key0 = k0 * 64; P.ctx_row0 = NLAT + b * CTXL; P.ycol = 512 + 64 * h;
        } else if (ui < 2048) {
            const int u = ui - 1536; kind = 3; cv_row0 = (u >> 6) * SEQ; cv_len = SEQ; cv_t0 = (u & 63) * 32;
        } else if (ui < 2112) {
            const int u = ui - 2048; kind = 3; cv_row0 = NLAT + (u >> 3) * CTXL; cv_len = CTXL; cv_t0 = (u & 7) * 32;
        } else {
            const bool isb = ui >= 2240; const int u = isb ? ui - 2240 : ui - 2176; const int b = u >> 3, hq = u & 7, n = hq >> 2;
            kind = 0;
            P.qrow = NLAT + b * CTXL + 32 * wid; P.nlat = 0; P.ntile = 4; P.lat_row0 = 0; P.ctx_row0 = NLAT + b * CTXL;
            if (isb) { P.qcol = 512 + 64 * hq; P.kcol = 1024 + 64 * hq; P.vcol = 1536 + 64 * hq; P.ycol = 512 + 64 * hq; }
            else { P.qcol = 2048 + 64 * hq; P.kcol = 2560 + 64 * n; P.vcol = 2688 + 64 * n; P.ycol = 1024 + 64 * hq; }
        }
        if ((KM & 1) && kind == 0) attn_unit<64, 64, 0, VAR>(lds, P, dry);
        if ((KM & 2) && kind == 1) attn_unit<64, 64, 1, VAR>(lds, P, dry);
        if ((KM & 4) && kind == 2) attn_unit<128, 128, 2, VAR>(lds, P, dry);
        if ((KM & 8) && kind == 3) conv_unit(lds, a, l, cv_row0, cv_len, cv_t0, dry);
    }
}

template <int J> __device__ __forceinline__ void run_phases(lds_t* lds) {
    cg::grid_group grid = cg::this_grid();
    int lo, hi; { KA a = get_args(); lo = a->ph_lo; hi = a->ph_hi; }
    { LAS float* ropeL = (LAS float*)(lds + AT_ROPE);
      for (int idx = threadIdx.x; idx < 1024; idx += 512) { const int pos = idx >> 4, i = idx & 15; const float ang = (float)pos * exp2f(-(float)i * (13.287712379549449f / 16.f)); ropeL[idx] = cosf(ang); ropeL[1024 + idx] = sinf(ang); }
      __syncthreads(); }
    XcdBarrier bar; bar.bar = nullptr; bar.x = 0; bar.st = nullptr;
    if (J < 0) {
        volatile LAS unsigned* st = (volatile LAS unsigned*)(lds + 131328);
        if (threadIdx.x < 2) st[threadIdx.x] = 0u;
        __syncthreads();
        KA a = get_args(); bar = xcd_barrier_post((unsigned*)(a->ws + WS_BAR), st);
        if (hi > 1000) grid.sync();
    }
#define KIND(j) (J < 0 || J == (j) || ((j) == 4 && J >= 40))
#define IN(k) (lo <= (k) && (k) < hi)
#define SEAM(k) do { if (J < 0) { if (IN(k) && IN((k) + 1)) { PROBE_LOOP(99) xcd_barrier(bar); } } } while (0)
#define WAVEIDS() const int tid = opaque_tid(), lane = tid & 63, wid = __builtin_amdgcn_readfirstlane(tid >> 6); const int G = gridDim.x, gw = blockIdx.x * 8 + wid, ngw = G * 8; (void)lane; (void)gw; (void)ngw; (void)G

    if (KIND(0) && IN(0)) PROBE_LOOP(0) {
        KA a = get_args(); WAVEIDS();
        float* mod = (float*)(a->ws + WS_MOD);
        LAS float* cs = (LAS float*)(lds + 73728);
        for (int i = tid; i < 9 * 1024; i += 512) { const float v = (i < 8192) ? a->in[1][i] : a->in[3][i - 8192]; cs[i] = silu(v); }
        __syncthreads();
        for (int it = gw; it < 769; it += ngw) {
            if (it < 768) {
                const int l = it / 384, n0 = (it % 384) * 8, col = n0 + (lane & 7), kg = lane >> 3;
                float acc[9];
#pragma unroll
                for (int r = 0; r < 9; ++r) acc[r] = 0.f;
                const float* w = a->in[4] + (size_t)l * DM * 3072 + col;
#pragma unroll 8
                for (int k = kg * 128; k < kg * 128 + 128; ++k) { const float wv = w[(size_t)k * 3072];
#pragma unroll
                    for (int r = 0; r < 9; ++r) acc[r] += cs[r * 1024 + k] * wv; }
#pragma unroll
                for (int r = 0; r < 9; ++r) { acc[r] += __shfl_xor(acc[r], 8); acc[r] += __shfl_xor(acc[r], 16); acc[r] += __shfl_xor(acc[r], 32); }
                if (lane < 8) {
                    const float bb = a->in[5][l * 3072 + col];
#pragma unroll
                    for (int r = 0; r < 9; ++r) mod[(size_t)(l * 9 + r) * 3072 + col] = acc[r] + bb; }
            } else {
                if (lane < 2) { const int l = lane; float s1 = 0.f, s2 = 0.f;
                    for (int e = 0; e < 64; ++e) { s1 += a->in[20][l * 64 + e] * a->in[21][l * 64 + e]; s2 += a->in[22][l * 64 + e] * a->in[23][l * 64 + e]; }
                    const float li = (l == 0) ? 0.2f : (0.8f - 0.6f * 0.7408182206817179f);
                    ((float*)(a->ws + WS_LAM))[l] = expf(s1) - expf(s2) + li; }
            }
        }
        convert_weights(a, 0, lds, gw, ngw, wid, lane, 769, 0, 7040);
    }
    SEAM(0);
#pragma unroll 1
    for (int L = 0; L < 2; ++L) {
        const int pb = 1 + 7 * L;
        if (KIND(1) && IN(pb + 0)) PROBE_LOOP(1) {
            KA a = get_args(); WAVEIDS();
            if (L == 1) convert_weights(a, 1, lds, gw, ngw, wid, lane, 0, (J < 0 && G == 256) ? 6528 : 0, 7040);
            norm_phase((L == 0) ? a->in[0] : a->out, (L == 0) ? a->in[2] : (const float*)(a->ws + WS_XC1), a->in[6] + L * DM, (const float*)(a->ws + WS_MOD) + (size_t)L * 9 * 3072, (bf16_t*)(a->ws + WS_HN), gw, ngw, lane);
        }
        SEAM(pb + 0);
        if (KIND(2) && IN(pb + 1)) PROBE_LOOP(2) {
            KA a = get_args();
            pg8::Gemm g{(const bf16_t*)(a->ws + WS_HN), (const bf16_t*)(a->ws + WS_W), NTOK, N1A, DM, DM, 0}; pg8::StaticOrder S; S.init(NTOK, N1A, (int)gridDim.x, (int)blockIdx.x);
            Epi1a E{(bf16_t*)(a->ws + WS_QKV), (bf16_t*)(a->ws + WS_Y), L, lds};
            pg8::gemm_phase<Epi1a, pg8::StaticOrder, true, true>(lds, g, S, E);
        }
        SEAM(pb + 1);
        if (KIND(4) && IN(pb + 3)) { { KA a = get_args(); mix_phase<(J < 0) ? 15 : (J >= 40 ? (1 << (J - 40)) : 15), 0>(lds, a, L, false); }
            if (PROBE_KIND >= 40 && PROBE_KIND <= 44) { _Pragma("unroll 1") for (int rep_ = 0; rep_ < PROBE_REP; ++rep_) { KA a = get_args(); mix_phase<(PROBE_KIND >= 40 && PROBE_KIND < 44) ? (1 << (PROBE_KIND - 40)) : 15, PROBE_VAR>(lds, a, L, a->ph_hi < 1000); } } }
        SEAM(pb + 3);
        const int Mmrg = (L == 0) ? NTOK : NLAT;
        if (KIND(5) && IN(pb + 4)) PROBE_LOOP(5) {
            KA a = get_args();
            pg8::Gemm g{(const bf16_t*)(a->ws + WS_HN), (const bf16_t*)(a->ws + WS_W) + (size_t)N1A * DM, Mmrg, NLOG, DM, DM, 0}; pg8::StaticOrder S; S.init(Mmrg, NLOG, (int)gridDim.x, (int)blockIdx.x);
            Epi1b E{(bf16_t*)(a->ws + WS_QKV), a->in[8] + L * NLOG};
            pg8::gemm_phase<Epi1b, pg8::StaticOrder, true, true>(lds, g, S, E);
        }
        SEAM(pb + 4);
        if (KIND(6) && IN(pb + 5)) PROBE_LOOP(6) {
            KA a = get_args();
            MergeOrder S; S.base.init(Mmrg, DM, (int)gridDim.x, (int)blockIdx.x);
            pg8::Gemm g{(const bf16_t*)(a->ws + WS_Y), (const bf16_t*)(a->ws + WS_WBR), Mmrg, 4 * DM, 512, YP, 1024};
            if (PROBE_VAR == 7 && rep_ > 0) { EpiNull E{(float*)(a->ws + WS_LAM + 64)}; pg8::gemm_phase<EpiNull, MergeOrder, true, true>(lds, g, S, E); }
            else {
            EpiM E{(const bf16_t*)(a->ws + WS_QKV), (bf16_t*)(a->ws + WS_HN), (bf16_t*)(a->ws + WS_VT)};
            pg8::gemm_phase<EpiM, MergeOrder, true, true>(lds, g, S, E); }
            if (J < 0 && L == 0 && gridDim.x == 256 && blockIdx.x >= 32) {
                KA a2 = get_args(); WAVEIDS();
                convert_weights(a2, 1, lds, (int)(blockIdx.x - 32) * 8 + wid, 224 * 8, wid, lane, 0, 0, 5504);
            }
        }
        SEAM(pb + 5);
        if (KIND(7) && IN(pb + 6)) PROBE_LOOP(7) {
            KA a = get_args();
            pg8::Gemm g{(const bf16_t*)(a->ws + WS_HN), (const bf16_t*)(a->ws + WS_WO), Mmrg, DM, DM, DM, 0}; pg8::StaticOrder S; S.init(Mmrg, DM, (int)gridDim.x, (int)blockIdx.x);
            EpiOut E{(L == 0) ? a->in[0] : a->out, (L == 0) ? a->in[2] : (const float*)(a->ws + WS_XC1), a->out, (float*)(a->ws + WS_XC1), (const float*)(a->ws + WS_MOD) + (size_t)L * 9 * 3072};
            pg8::gemm_phase<EpiOut, pg8::StaticOrder, true, true>(lds, g, S, E);
            if (J < 0 && L == 0 && gridDim.x == 256 && blockIdx.x >= 32) {
                KA a2 = get_args(); WAVEIDS();
                convert_weights(a2, 1, lds, (int)(blockIdx.x - 32) * 8 + wid, 224 * 8, wid, lane, 0, 5504, 6528);
            }
        }
        if (L == 0) SEAM(pb + 6);
    }
#undef IN
#undef SEAM
#undef WAVEIDS
#undef KIND
}
template <int J> __global__ void __launch_bounds__(512, 2) fwd_kernel(Args a_unused) {
    extern __shared__ __attribute__((aligned(16))) unsigned char lds_raw[];
    run_phases<J>((lds_t*)lds_raw);
}

#if MK_ONE
#define MAINK fwd_kernel<-1>
#else
#define MAINK fwd_kernel<0>
#endif
extern "C" void kernel_launch(void* const* d_in, const int* in_sizes, int n_in, void* d_out, int out_size, void* d_ws, size_t ws_size, hipStream_t stream) {
    static int grid = 0;
    if (grid == 0) {
        if (n_in != 30 || out_size != NLAT * DM || ws_size < WS_END) { fprintf(stderr, "kernel_launch: unexpected problem (n_in %d, out %d, ws %zu < %zu)\n", n_in, out_size, ws_size, (size_t)WS_END); grid = -1; return; }
        int dev = 0, cus = 0, per_cu = 0;
        if (hipGetDevice(&dev) != hipSuccess || hipDeviceGetAttribute(&cus, hipDeviceAttributeMultiprocessorCount, dev) != hipSuccess) { grid = -1; return; }
        if (hipFuncSetAttribute((const void*)MAINK, hipFuncAttributeMaxDynamicSharedMemorySize, LDS_BYTES) != hipSuccess) { fprintf(stderr, "kernel_launch: hipFuncSetAttribute failed\n"); grid = -1; return; }
        if (hipOccupancyMaxActiveBlocksPerMultiprocessor(&per_cu, (const void*)MAINK, 512, LDS_BYTES) != hipSuccess || per_cu < 1) { fprintf(stderr, "kernel_launch: occupancy query gave %d\n", per_cu); per_cu = 1; }
        (void)hipGetLastError();
#if !MK_ONE
#define SETLDS(J) (void)hipFuncSetAttribute((const void*)fwd_kernel<J>, hipFuncAttributeMaxDynamicSharedMemorySize, LDS_BYTES)
        SETLDS(0); SETLDS(1); SETLDS(2); SETLDS(3); SETLDS(40); SETLDS(41); SETLDS(42); SETLDS(43); SETLDS(5); SETLDS(6); SETLDS(7);
#endif
        grid = cus;
    }
    if (grid < 0) return;
    Args a{};
    for (int i = 0; i < 30; ++i) a.in[i] = (const float*)d_in[i];
    a.out = (float*)d_out; a.ws = (unsigned char*)d_ws;
#if MK_ONE
    if (hipMemsetAsync((char*)d_ws + WS_BAR, 0, 16384, stream) != hipSuccess) { fprintf(stderr, "kernel_launch: memset of barrier words failed\n"); return; }
    a.ph_lo = 0; a.ph_hi = NPHASE;
    void* args[] = {&a};
    hipError_t e = hipLaunchCooperativeKernel((const void*)fwd_kernel<-1>, dim3(grid), dim3(512), args, LDS_BYTES, stream);
    if (e != hipSuccess) fprintf(stderr, "kernel_launch: cooperative launch failed: %s (grid %d)\n", hipGetErrorString(e), grid);
#else
#define LAUNCH1(J, p) do { a.ph_lo = (p); a.ph_hi = (p) + 1; hipLaunchKernelGGL(fwd_kernel<J>, dim3(grid), dim3(512), LDS_BYTES, stream, a); } while (0)
    LAUNCH1(0, 0);
    for (int L = 0; L < 2; ++L) { const int pb = 1 + 7 * L;
        LAUNCH1(1, pb + 0); LAUNCH1(2, pb + 1); LAUNCH1(3, pb + 2);
        LAUNCH1(42, pb + 3); LAUNCH1(40, pb + 3); LAUNCH1(41, pb + 3); LAUNCH1(43, pb + 3);
        LAUNCH1(5, pb + 4); LAUNCH1(6, pb + 5); LAUNCH1(7, pb + 6); }
#endif
}
```

```cpp
#include <hip/hip_runtime.h>
#include <hip/hip_cooperative_groups.h>
#include <cstdio>
#include <cstdint>
namespace cg = cooperative_groups;
namespace pg8 {
#define PG8_LAS __attribute__((address_space(3)))
typedef unsigned short bf16_t;
typedef short bf16x8 __attribute__((ext_vector_type(8)));
typedef float f32x4 __attribute__((ext_vector_type(4)));
typedef unsigned u32x4 __attribute__((ext_vector_type(4)));
constexpr int BM = 256, BK = 64, HALF = 128, HTB = HALF * BK * 2  , STAGE_BYTES = 8 * HTB, NXCD = 8, WGM = 8;

__host__ __device__ __forceinline__ int lds_byte(int r, int c) { const int st = (r >> 4) * 2 + (c >> 5), rr = r & 15, cc = c & 31, ob = rr * 64 + cc * 2; return st * 1024 + (ob ^ (((ob >> 9) & 1) << 5)); }
__host__ __device__ __forceinline__ void stage_rc(int b, int& R, int& C) { const int st = b / 1024, sb = b % 1024, swz = sb ^ (((sb >> 9) & 1) << 5); R = (st >> 1) * 16 + swz / 64; C = (st & 1) * 32 + (swz % 64) / 2; }
__host__ __device__ __forceinline__ int perm32(int rho) { const int n = rho >> 4, i = rho & 15; return 8 * (i >> 2) + 4 * n + (i & 3); }

struct Unit { int pm, pn; };
struct Gemm { const bf16_t* A; const bf16_t* Bt; int M, N, K, lda, acs; };

struct StaticOrder {
    int nM, nN, nwg, G, c;
    __host__ __device__ void init(int M, int N, int G_, int c_) { nM = M / BM; nN = N / BM; nwg = nM * nN; G = G_; c = c_; }
    __host__ __device__ bool next(int i, Unit& u) const {
        const long L = (long)i * G + c; if (L >= nwg) return false;
        int wgid = (int)L; { const int q = nwg / NXCD, r = nwg % NXCD, xcd = wgid % NXCD, off = wgid / NXCD; wgid = (xcd < r ? xcd * (q + 1) : r * (q + 1) + (xcd - r) * q) + off; }
        const int nig = WGM * nN, gid = wgid / nig, fm = gid * WGM, gsz = (nM - fm) < WGM ? (nM - fm) : WGM;
        u.pm = fm + ((wgid % nig) % gsz); u.pn = (wgid % nig) / gsz; return true;
    }
    __device__ __forceinline__ void a_ready(const Unit&) const {}
    __device__ __forceinline__ void done(const Unit&) const {}
};

template <class Epi, class Sched, bool ALIGN_EPI = false, bool SP2 = false>
__device__ __forceinline__ void gemm_phase(PG8_LAS unsigned char* lds, const Gemm g, const Sched& S, const Epi& E) {
    int tid = threadIdx.x; asm volatile("" : "+v"(tid)); const int wid = __builtin_amdgcn_readfirstlane(tid >> 6), lane = tid & 63, wr = wid >> 2, wc = wid & 3, fr = lane & 15, fq = lane >> 4;
    const int K = g.K, nt = K / BK;
    unsigned voffA[2], voffB[2];
#pragma unroll
    for (int i = 0; i < 2; ++i) { int R, C; stage_rc(tid * 16 + i * 8192, R, C); const int Rb = Epi::PERM ? ((R & ~31) + perm32(R & 31)) : R;
        voffA[i] = (unsigned)(R * g.lda + C) * 2u; voffB[i] = (unsigned)(Rb * K + C) * 2u; }
    const size_t kstep = (size_t)(BK * 2);
    const size_t hstep = (size_t)HALF * K * 2;
    const size_t tstep = 2 * hstep; const size_t hstepA = (size_t)HALF * g.lda * 2, tstepA = 2 * hstepA;
    const unsigned ldsw = (unsigned)wid * 1024u;
    const int aoff = lds_byte(wr * 64 + fr, fq * 8), boff = lds_byte(wc * 32 + fr, fq * 8);
#define PG8_SA(b, h) (((b) * 2 + (h)) * HTB)
#define PG8_SB(b, h) ((4 + (b) * 2 + (h)) * HTB)
#define PG8_STAGE(bufoff, gbase, voff) do { _Pragma("unroll") for (int _i = 0; _i < 2; ++_i) \
        __builtin_amdgcn_global_load_lds((const unsigned*)((const char*)(gbase) + (voff)[_i]), (PG8_LAS unsigned*)(lds + (bufoff) + ldsw + _i * 8192), 16, 0, 0); } while (0)
#define PG8_LDA(dst, b, h) do { _Pragma("unroll") for (int m = 0; m < 4; ++m) _Pragma("unroll") for (int k = 0; k < 2; ++k) dst[m][k] = *(const PG8_LAS bf16x8*)(lds + PG8_SA(b, h) + aoff + m * 2048 + k * 1024); } while (0)
#define PG8_LDB(dst, b, h) do { _Pragma("unroll") for (int n = 0; n < 2; ++n) _Pragma("unroll") for (int k = 0; k < 2; ++k) dst[n][k] = *(const PG8_LAS bf16x8*)(lds + PG8_SB(b, h) + boff + n * 2048 + k * 1024); } while (0)
#define PG8_MMA(ai, bj, At, Bt) do { __builtin_amdgcn_s_setprio(1); _Pragma("unroll") for (int m = 0; m < 4; ++m) _Pragma("unroll") for (int n = 0; n < 2; ++n) _Pragma("unroll") for (int k = 0; k < 2; ++k) \
        acc[ai][bj][m][n] = __builtin_amdgcn_mfma_f32_16x16x32_bf16(Bt[n][k], At[m][k], acc[ai][bj][m][n], 0, 0, 0); __builtin_amdgcn_s_setprio(0); } while (0)
#define PG8_WAIT_V(n) asm volatile("s_waitcnt vmcnt(" #n ")" ::: "memory")
#define PG8_WAIT_L(n) asm volatile("s_waitcnt lgkmcnt(" #n ")" ::: "memory")
#define PG8_BAR __builtin_amdgcn_s_barrier()
#define PG8_SCHED __builtin_amdgcn_sched_barrier(0)
    Unit cur, nxt; int ui = 0;
    if (!S.next(0, cur)) return;
    f32x4 acc[2][2][4][2];
#pragma unroll
    for (int a = 0; a < 2; ++a)
#pragma unroll
        for (int b = 0; b < 2; ++b)
#pragma unroll
            for (int m = 0; m < 4; ++m)
#pragma unroll
                for (int n = 0; n < 2; ++n) acc[a][b][m][n] = (f32x4){0.f, 0.f, 0.f, 0.f};
    bf16x8 At[4][2], B0[2][2], B1[2][2];
    const char* cA = (const char*)g.A + (size_t)cur.pm * tstepA + (size_t)(cur.pn >> 2) * g.acs; const char* cB = (const char*)g.Bt + (size_t)cur.pn * tstep;
    S.a_ready(cur);
    if constexpr (SP2) {
        PG8_STAGE(PG8_SB(0, 0), cB, voffB); PG8_STAGE(PG8_SB(0, 1), cB + hstep, voffB); PG8_STAGE(PG8_SA(0, 0), cA, voffA); PG8_STAGE(PG8_SA(0, 1), cA + hstepA, voffA);
        if (wr == 1) PG8_BAR;
        PG8_WAIT_V(2); PG8_BAR;
        PG8_STAGE(PG8_SB(1, 0), cB + kstep, voffB); PG8_STAGE(PG8_SA(1, 0), cA + kstep, voffA); PG8_STAGE(PG8_SB(1, 1), cB + hstep + kstep, voffB);
        PG8_WAIT_V(6); PG8_BAR;
    } else {
        PG8_STAGE(PG8_SB(0, 0), cB, voffB); PG8_STAGE(PG8_SA(0, 0), cA, voffA); PG8_STAGE(PG8_SB(0, 1), cB + hstep, voffB); PG8_STAGE(PG8_SA(0, 1), cA + hstepA, voffA);
        if (wr == 1) PG8_BAR;
        PG8_WAIT_V(4); PG8_BAR;
        PG8_STAGE(PG8_SB(1, 0), cB + kstep, voffB); PG8_STAGE(PG8_SA(1, 0), cA + kstep, voffA); PG8_STAGE(PG8_SB(1, 1), cB + hstep + kstep, voffB);
        PG8_WAIT_V(6); PG8_BAR;
    }
    for (;;) {
        const bool has_next = S.next(ui + 1, nxt);
        const char* nA = has_next ? (const char*)g.A + (size_t)nxt.pm * tstepA + (size_t)(nxt.pn >> 2) * g.acs : cA; const char* nB = has_next ? (const char*)g.Bt + (size_t)nxt.pn * tstep : cB;
        for (int t = 0; t < nt; t += 2) {
            const bool last = (t == nt - 2);
            const char* a1 = cA + (size_t)(t + 1) * kstep;
            const char* a2 = last ? nA : cA + (size_t)(t + 2) * kstep; const char* b2 = last ? nB : cB + (size_t)(t + 2) * kstep;
            const char* a3 = a2 + kstep; const char* b3 = b2 + kstep;
            if (last && has_next) S.a_ready(nxt);
            if constexpr (SP2) {
            PG8_LDB(B0, 0, 0); PG8_LDB(B1, 0, 1); PG8_SCHED; PG8_LDA(At, 0, 0); PG8_STAGE(PG8_SA(1, 1), a1 + hstepA, voffA);
            PG8_WAIT_V(8); PG8_WAIT_L(0); PG8_BAR; PG8_MMA(0, 0, At, B0); PG8_MMA(0, 1, At, B1); PG8_BAR; PG8_SCHED;
            PG8_LDA(At, 0, 1); PG8_STAGE(PG8_SB(0, 0), b2, voffB); PG8_STAGE(PG8_SB(0, 1), b2 + hstep, voffB); PG8_STAGE(PG8_SA(0, 0), a2, voffA);
            PG8_WAIT_V(8); PG8_WAIT_L(0); PG8_BAR; PG8_MMA(1, 0, At, B0); PG8_MMA(1, 1, At, B1); PG8_BAR; PG8_SCHED;
            PG8_LDB(B0, 1, 0); PG8_LDB(B1, 1, 1); PG8_SCHED; PG8_LDA(At, 1, 0); PG8_STAGE(PG8_SA(0, 1), a2 + hstepA, voffA);
            PG8_WAIT_V(8); PG8_WAIT_L(0); PG8_BAR; PG8_MMA(0, 0, At, B0); PG8_MMA(0, 1, At, B1); PG8_BAR; PG8_SCHED;
            PG8_LDA(At, 1, 1); PG8_STAGE(PG8_SB(1, 0), b3, voffB); PG8_STAGE(PG8_SB(1, 1), b3 + hstep, voffB); PG8_STAGE(PG8_SA(1, 0), a3, voffA);
            PG8_WAIT_V(8); PG8_WAIT_L(0); PG8_BAR; PG8_MMA(1, 0, At, B0); PG8_MMA(1, 1, At, B1); PG8_BAR; PG8_SCHED;
            } else {
            PG8_LDB(B0, 0, 0); PG8_SCHED; PG8_LDA(At, 0, 0); PG8_STAGE(PG8_SA(1, 1), a1 + hstepA, voffA);
            PG8_WAIT_L(8); PG8_BAR; PG8_WAIT_L(0); PG8_MMA(0, 0, At, B0); PG8_BAR; PG8_SCHED;
            PG8_LDB(B1, 0, 1); PG8_STAGE(PG8_SB(0, 0), b2, voffB);
            PG8_BAR; PG8_WAIT_L(0); PG8_MMA(0, 1, At, B1); PG8_BAR;
            PG8_LDA(At, 0, 1); PG8_STAGE(PG8_SA(0, 0), a2, voffA);
            PG8_BAR; PG8_WAIT_L(0); PG8_MMA(1, 0, At, B0); PG8_BAR; PG8_SCHED;
            PG8_STAGE(PG8_SB(0, 1), b2 + hstep, voffB);
            PG8_WAIT_V(6); PG8_BAR; PG8_MMA(1, 1, At, B1); PG8_BAR;
            PG8_LDB(B0, 1, 0); PG8_SCHED; PG8_LDA(At, 1, 0); PG8_STAGE(PG8_SA(0, 1), a2 + hstepA, voffA);
            PG8_WAIT_L(8); PG8_BAR; PG8_WAIT_L(0); PG8_MMA(0, 0, At, B0); PG8_BAR; PG8_SCHED;
            PG8_LDB(B1, 1, 1); PG8_STAGE(PG8_SB(1, 0), b3, voffB);
            PG8_BAR; PG8_WAIT_L(0); PG8_MMA(0, 1, At, B1); PG8_BAR;
            PG8_LDA(At, 1, 1); PG8_STAGE(PG8_SA(1, 0), a3, voffA);
            PG8_BAR; PG8_WAIT_L(0); PG8_MMA(1, 0, At, B0); PG8_BAR; PG8_SCHED;
            PG8_STAGE(PG8_SB(1, 1), b3 + hstep, voffB);
            PG8_WAIT_V(6); PG8_BAR; PG8_MMA(1, 1, At, B1); PG8_BAR;
            }
        }
        if constexpr (ALIGN_EPI) { if (wr == 0) PG8_BAR; }
        if constexpr (!Epi::AFTER_DRAIN) { E(acc, cur, wr, wc, fr, fq); S.done(cur); }
        if (!has_next) break;
#pragma unroll
        for (int a = 0; a < 2; ++a)
#pragma unroll
            for (int b = 0; b < 2; ++b)
#pragma unroll
                for (int m = 0; m < 4; ++m)
#pragma unroll
                    for (int n = 0; n < 2; ++n) acc[a][b][m][n] = (f32x4){0.f, 0.f, 0.f, 0.f};
        cur = nxt; cA = nA; cB = nB; ++ui;
        if constexpr (ALIGN_EPI) { if (wr == 1) PG8_BAR; }
    }
    PG8_WAIT_V(0);
    if constexpr (!ALIGN_EPI) { if (wr == 0) PG8_BAR; }
    PG8_BAR;
    if constexpr (Epi::AFTER_DRAIN) { E.fused(acc, cur, wr, wc, fr, fq, lds, wid, lane); S.done(cur); }
#undef PG8_SA
#undef PG8_SB
#undef PG8_STAGE
#undef PG8_LDA
#undef PG8_LDB
#undef PG8_MMA
#undef PG8_WAIT_V
#undef PG8_WAIT_L
#undef PG8_BAR
#undef PG8_SCHED
}
}

#ifndef MK_ONE
#define MK_ONE 1
#endif
#ifndef PROBE_KIND
#define PROBE_KIND (-1)
#endif
#ifndef PROBE_REP
#define PROBE_REP 0
#endif
#ifndef PROBE_VAR
#define PROBE_VAR 0
#endif
#define PROBE_LOOP(kind) _Pragma("unroll 1") for (int rep_ = 0; rep_ < ((PROBE_KIND == (kind)) ? 1 + PROBE_REP : 1); ++rep_)
#define LAS __attribute__((address_space(3)))
typedef unsigned short bf16_t;
typedef short bf16x8 __attribute__((ext_vector_type(8)));
typedef short s16x4 __attribute__((ext_vector_type(4)));
typedef float f32x4 __attribute__((ext_vector_type(4)));
typedef float f32x16 __attribute__((ext_vector_type(16)));
typedef unsigned u32x4 __attribute__((ext_vector_type(4)));
typedef unsigned u32x2 __attribute__((ext_vector_type(2)));
typedef LAS unsigned char lds_t;

constexpr int BATCH = 8, SEQ = 2048, DM = 1024, CTXL = 256, NLAT = BATCH * SEQ, NCTX = BATCH * CTXL, NTOK = NLAT + NCTX;
constexpr int INW = 11008, N1A = 6912, NLOG = 4096;
constexpr int QP = 4352;
constexpr int YP = 2048;
constexpr int KEYS = SEQ + CTXL, VTR = 1152;
constexpr float EPSN = 1e-6f;
constexpr float C2 = 0.125f * 1.4426950408889634f;
constexpr float LOG2E = 1.4426950408889634f;

constexpr size_t WS_MOD = 4096, WS_ROPE = 262144, WS_LAM = 300000, WS_BAR = 524288, WS_W = 1048576;
constexpr size_t SZ_WIN = (size_t)INW * DM * 2, SZ_WBR = (size_t)4 * DM * 512 * 2, SZ_WO = (size_t)DM * DM * 2;
constexpr size_t WS_WBR = WS_W + SZ_WIN, WS_WO = WS_WBR + SZ_WBR;
constexpr size_t WS_HN = WS_WO + SZ_WO;
constexpr size_t WS_VT = WS_HN + (size_t)NTOK * DM * 2;
constexpr size_t WS_QKV = WS_VT + (size_t)BATCH * VTR * KEYS * 2;
constexpr size_t WS_Y = WS_QKV + (size_t)NTOK * QP * 2;
constexpr size_t WS_XC1 = WS_Y + (size_t)NTOK * YP * 2;
constexpr size_t WS_END = WS_XC1 + (size_t)NCTX * DM * 4;
constexpr int LDS_BYTES = 147456;
constexpr int AT_ROPE = 132096;
constexpr int NPHASE = 15;

struct Args { const float* in[30]; float* out; unsigned char* ws; int ph_lo, ph_hi; };
typedef const __attribute__((address_space(4))) Args* KA;
__device__ __forceinline__ int opaque_tid() { int t = threadIdx.x; asm volatile("" : "+v"(t)); return t; }
__device__ __forceinline__ KA get_args() { KA p = (KA)__builtin_amdgcn_kernarg_segment_ptr(); asm volatile("" : "+s"(p)); return p; }

__device__ __forceinline__ float bf2f(unsigned h) { return __uint_as_float(h << 16); }
__device__ __forceinline__ unsigned pk2(float lo, float hi) { typedef float f2 __attribute__((ext_vector_type(2))); typedef __bf16 b2 __attribute__((ext_vector_type(2))); f2 v = {lo, hi}; b2 b = __builtin_convertvector(v, b2); return __builtin_bit_cast(unsigned, b); }
__device__ __forceinline__ unsigned f2bf(float f) { return pk2(f, 0.f) & 0xffffu; }
__device__ __forceinline__ float fexp2(float x) { return __builtin_amdgcn_exp2f(x); }
__device__ __forceinline__ float sigm(float x) { return __builtin_amdgcn_rcpf(1.f + fexp2(-x * LOG2E)); }
__device__ __forceinline__ float silu(float x) { return x * sigm(x); }
__device__ __forceinline__ float wave_sum(float v) {
#pragma unroll
    for (int o = 1; o < 64; o <<= 1) v += __shfl_xor(v, o);
    return v;
}
__device__ __forceinline__ void unpack8(u32x4 w, float* x) {
    x[0] = bf2f(w.x & 0xffffu); x[1] = __uint_as_float(w.x & 0xffff0000u); x[2] = bf2f(w.y & 0xffffu); x[3] = __uint_as_float(w.y & 0xffff0000u);
    x[4] = bf2f(w.z & 0xffffu); x[5] = __uint_as_float(w.z & 0xffff0000u); x[6] = bf2f(w.w & 0xffffu); x[7] = __uint_as_float(w.w & 0xffff0000u);
}
#define LDS_WAIT() asm volatile("s_waitcnt lgkmcnt(0)" ::: "memory")

#define XB_TMO      128
#define XB_XCNT(j)  (256  + 64 * (j))
#define XB_XSUB(j)  (1280 + 64 * (j))
#define XB_XGEN(j)  (2304 + 64 * (j))
#define XB_TOP      3328
#define XB_TOPGEN   3392
#define XCD_BAR_WORDS 3456
#define XB_SPIN_CAP (1u << 18)

__device__ __forceinline__ unsigned xb_ld(unsigned* p)              { return __hip_atomic_load(p, __ATOMIC_RELAXED, __HIP_MEMORY_SCOPE_AGENT); }
__device__ __forceinline__ unsigned xb_add(unsigned* p, unsigned v) { return __hip_atomic_fetch_add(p, v, __ATOMIC_RELAXED, __HIP_MEMORY_SCOPE_AGENT); }
__device__ __forceinline__ unsigned xb_xcc_id() { return (unsigned)__builtin_amdgcn_s_getreg((3 << 11) | 20) & 0xFu; }
#define XB_SPIN(cond, bar) do { unsigned _sp = 0; while (cond) { __builtin_amdgcn_s_sleep(1); \
    if ((++_sp & 255u) == 0u) { if (xb_ld(&(bar)[XB_TMO])) break; if (_sp > XB_SPIN_CAP) { atomicAdd(&(bar)[XB_TMO], 1u); break; } } } } while (0)

struct XcdBarrier {
    unsigned* bar; unsigned x;
    volatile LAS unsigned* st;
};

__device__ __forceinline__ XcdBarrier xcd_barrier_post(unsigned* bar, volatile LAS unsigned* st) {
    XcdBarrier b; b.bar = bar; b.x = xb_xcc_id(); b.st = st;
    if (threadIdx.x == 0) (void)xb_add(&bar[XB_XCNT(b.x)], 1u);
    return b;
}
__device__ __forceinline__ void xcd_barrier_complete(unsigned* bar, unsigned x, unsigned& nloc, unsigned& nx) {
    const unsigned G = gridDim.x * gridDim.y * gridDim.z;
    unsigned sum, cnt, mine, sp = 0u;
    for (;;) {
        sum = 0u; cnt = 0u; mine = 0u;
#pragma unroll
        for (unsigned j = 0; j < 16; ++j) { const unsigned c = xb_ld(&bar[XB_XCNT(j)]); sum += c; cnt += (c > 0u) ? 1u : 0u; mine = (j == x) ? c : mine; }
        if (sum == G) break;
        __builtin_amdgcn_s_sleep(1);
        if ((++sp & 255u) == 0u) { if (xb_ld(&bar[XB_TMO])) break; if (sp > XB_SPIN_CAP) { atomicAdd(&bar[XB_TMO], 1u); break; } }
    }
    nloc = mine > 0u ? mine : 1u; nx = cnt > 0u ? cnt : 1u;
}

__device__ __forceinline__ void xcd_barrier(const XcdBarrier& b) {
    asm volatile("s_waitcnt vmcnt(0)" ::: "memory");
    __syncthreads();
    if (threadIdx.x == 0) {
        unsigned* bar = b.bar;
        __builtin_amdgcn_s_waitcnt(0);
        unsigned nloc = b.st[0], nx = b.st[1];
        if (nloc == 0u) { xcd_barrier_complete(bar, b.x, nloc, nx); b.st[0] = nloc; b.st[1] = nx; }
        const unsigned old = xb_add(&bar[XB_XSUB(b.x)], 1u);
        const unsigned gen = old / nloc;
        if (old + 1u == (gen + 1u) * nloc) {
            __builtin_amdgcn_fence(__ATOMIC_RELEASE, "agent");
            asm volatile("s_waitcnt vmcnt(0)" ::: "memory");
            const unsigned og = xb_add(&bar[XB_TOP], 1u);
            const unsigned tg = og / nx;
            if (og + 1u == (tg + 1u) * nx) xb_add(&bar[XB_TOPGEN], 1u);
            else XB_SPIN(xb_ld(&bar[XB_TOPGEN]) == tg, bar);
            __builtin_amdgcn_fence(__ATOMIC_ACQUIRE, "agent");
            xb_add(&bar[XB_XGEN(b.x)], 1u);
            asm volatile("s_waitcnt vmcnt(0)" ::: "memory");
        } else {
            XB_SPIN(xb_ld(&bar[XB_XGEN(b.x)]) == gen, bar);
            __builtin_amdgcn_fence(__ATOMIC_ACQUIRE, "agent");
            asm volatile("s_waitcnt vmcnt(0)" ::: "memory");
        }
    }
    __syncthreads();
}

struct Epi1a {
    static constexpr bool PERM = true, AFTER_DRAIN = false;
    bf16_t* qkv; bf16_t* gates; int L; const lds_t* ldsb;
    __device__ __forceinline__ void operator()(const f32x4 (&acc)[2][2][4][2], const pg8::Unit& u, int wr, int wc, int fr, int fq) const {
        const int pn = u.pn; const int row0 = u.pm * 256 + wr * 64 + fr; const int cw = wc * 32 + 8 * fq;
        const bool headtile = (pn >= 6 && pn < 10) || (pn >= 14 && pn < 17) || (pn >= 19 && pn < 23);
        if (headtile) {
            KA a = get_args();
            const int cb = (pn < 12 ? 512 + (pn - 6) * 256 : (pn < 17 ? 2048 + (pn - 14) * 256 : 2816 + (pn - 19) * 256)) + 64 * wc;
            const bool plain = (pn == 16) && (wc >= 2);
            const int gi = pn < 8 ? 13 : (pn < 10 ? 14 : (pn < 16 ? 16 : (pn == 16 ? 17 : (pn < 21 ? 18 : 19))));
            const bool isq = (pn < 8) || (pn == 14) || (pn == 15) || (pn == 19) || (pn == 20);
            const bool rot = (pn >= 14) && (u.pm < 64);
            const int hh = fq >> 1, e0 = 32 * hh + 8 * (fq & 1);
            const float* gp = a->in[gi] + L * 64 + e0;
            const LAS float* rope = (const LAS float*)(ldsb + AT_ROPE) + 8 * (fq & 1);
            f32x4 g4[2][2];
#pragma unroll
            for (int bj = 0; bj < 2; ++bj)
#pragma unroll
                for (int n = 0; n < 2; ++n) g4[bj][n] = *(const f32x4*)(gp + 16 * bj + 4 * n);
            const float qs = isq ? C2 : 1.f;
#pragma unroll
            for (int ai = 0; ai < 2; ++ai)
#pragma unroll
                for (int m = 0; m < 4; ++m) {
                    const int row = row0 + ai * 128 + m * 16;
                    f32x4 v[2][2];
#pragma unroll
                    for (int bj = 0; bj < 2; ++bj)
#pragma unroll
                        for (int n = 0; n < 2; ++n) v[bj][n] = acc[ai][bj][m][n];
                    if (!plain) {
                        float ss = 0.f;
#pragma unroll
                        for (int bj = 0; bj < 2; ++bj)
#pragma unroll
                            for (int n = 0; n < 2; ++n) ss += (v[bj][n][0] * v[bj][n][0] + v[bj][n][1] * v[bj][n][1]) + (v[bj][n][2] * v[bj][n][2] + v[bj][n][3] * v[bj][n][3]);
                        ss += __shfl_xor(ss, 16); ss += __shfl_xor(ss, 32);
                        const float rstd = rsqrtf(ss * (1.f / 64.f) + EPSN) * qs;
#pragma unroll
                        for (int bj = 0; bj < 2; ++bj)
#pragma unroll
                            for (int n = 0; n < 2; ++n) v[bj][n] = v[bj][n] * rstd * g4[bj][n];
                        if (rot) {
                            const int t = row & (SEQ - 1); const int pos = hh == 0 ? (t >> 6) : (t & 63);
#pragma unroll
                            for (int n = 0; n < 2; ++n) {
                                const f32x4 cs = *(const LAS f32x4*)(rope + pos * 16 + 4 * n), sn = *(const LAS f32x4*)(rope + 1024 + pos * 16 + 4 * n);
                                const f32x4 x1 = v[0][n], x2 = v[1][n];
                                v[0][n] = x1 * cs - x2 * sn; v[1][n] = x2 * cs + x1 * sn; }
                        }
                    }
                    bf16_t* rowp = qkv + (size_t)row * QP + cb + e0;
#pragma unroll
                    for (int bj = 0; bj < 2; ++bj) { u32x4 w; w.x = pk2(v[bj][0][0], v[bj][0][1]); w.y = pk2(v[bj][0][2], v[bj][0][3]); w.z = pk2(v[bj][1][0], v[bj][1][1]); w.w = pk2(v[bj][1][2], v[bj][1][3]); *(u32x4*)(rowp + 16 * bj) = w; }
                    asm volatile("" ::: "memory");
                }
        } else if (pn < 4) {
            bf16_t* base = qkv + (size_t)row0 * QP + pn * 128 + cw;
#pragma unroll
            for (int ai = 0; ai < 2; ++ai)
#pragma unroll
                for (int m = 0; m < 4; ++m) {
                    const f32x4 a0 = acc[ai][0][m][0], a1 = acc[ai][0][m][1], g0 = acc[ai][1][m][0], g1 = acc[ai][1][m][1];
                    u32x4 w;
                    w.x = pk2(a0[0] * sigm(g0[0]), a0[1] * sigm(g0[1])); w.y = pk2(a0[2] * sigm(g0[2]), a0[3] * sigm(g0[3]));
                    w.z = pk2(a1[0] * sigm(g1[0]), a1[1] * sigm(g1[1])); w.w = pk2(a1[2] * sigm(g1[2]), a1[3] * sigm(g1[3]));
                    *(u32x4*)(base + (size_t)(ai * 128 + m * 16) * QP) = w;
                }
        } else {
            bf16_t* dst; int ldc, cb;
            if (pn < 6) { dst = gates; ldc = YP; cb = (pn - 4) * 256; }
            else if (pn < 12) { dst = qkv; ldc = QP; cb = 512 + (pn - 6) * 256; }
            else if (pn < 14) { dst = gates; ldc = YP; cb = 512 + (pn - 12) * 256; }
            else if (pn < 17) { dst = qkv; ldc = QP; cb = 2048 + (pn - 14) * 256; }
            else if (pn < 19) { dst = gates; ldc = YP; cb = 1024 + (pn - 17) * 256; }
            else if (pn < 25) { dst = qkv; ldc = QP; cb = 2816 + (pn - 19) * 256; }
            else { dst = gates; ldc = YP; cb = 1536 + (pn - 25) * 256; }
#pragma unroll
            for (int ai = 0; ai < 2; ++ai)
#pragma unroll
                for (int m = 0; m < 4; ++m) {
                    bf16_t* rowp = dst + (size_t)(row0 + ai * 128 + m * 16) * ldc + cb + cw;
#pragma unroll
                    for (int bj = 0; bj < 2; ++bj) {
                        const f32x4 v0 = acc[ai][bj][m][0], v1 = acc[ai][bj][m][1];
                        u32x4 w; w.x = pk2(v0[0], v0[1]); w.y = pk2(v0[2], v0[3]); w.z = pk2(v1[0], v1[1]); w.w = pk2(v1[2], v1[3]);
                        *(u32x4*)(rowp + bj * 128) = w;
                    }
                }
        }
    }
};
struct Epi1b {
    static constexpr bool PERM = true, AFTER_DRAIN = false;
    bf16_t* G; const float* bm;
    __device__ __forceinline__ void operator()(const f32x4 (&acc)[2][2][4][2], const pg8::Unit& u, int wr, int wc, int fr, int fq) const {
        const int row0 = u.pm * 256 + wr * 64 + fr; const int col0 = u.pn * 256 + wc * 32 + 8 * fq;
        f32x4 bv[2][2];
#pragma unroll
        for (int bj = 0; bj < 2; ++bj)
#pragma unroll
            for (int n = 0; n < 2; ++n) bv[bj][n] = *(const f32x4*)(bm + col0 + bj * 128 + 4 * n);
#pragma unroll
        for (int ai = 0; ai < 2; ++ai)
#pragma unroll
            for (int m = 0; m < 4; ++m) {
                bf16_t* rowp = G + ((((size_t)(u.pm * 16 + u.pn) * 8 + wr * 4 + wc) * 16 + (ai * 8 + m * 2)) * 64 + fq * 16 + fr) * 8;
#pragma unroll
                for (int bj = 0; bj < 2; ++bj) {
                    const f32x4 v0 = acc[ai][bj][m][0] + bv[bj][0], v1 = acc[ai][bj][m][1] + bv[bj][1];
                    u32x4 w; w.x = pk2(sigm(v0[0]), sigm(v0[1])); w.y = pk2(sigm(v0[2]), sigm(v0[3])); w.z = pk2(sigm(v1[0]), sigm(v1[1])); w.w = pk2(sigm(v1[2]), sigm(v1[3]));
                    *(u32x4*)(rowp + bj * 512) = w;
                }
            }
    }
};
struct EpiNull { static constexpr bool PERM = true, AFTER_DRAIN = false; float* sink;
    __device__ __forceinline__ void operator()(const f32x4 (&acc)[2][2][4][2], const pg8::Unit& u, int wr, int wc, int fr, int fq) const {
        float t = 0.f;
#pragma unroll
        for (int ai = 0; ai < 2; ++ai)
#pragma unroll
            for (int bj = 0; bj < 2; ++bj)
#pragma unroll
                for (int m = 0; m < 4; ++m)
#pragma unroll
                    for (int n = 0; n < 2; ++n) t += acc[ai][bj][m][n][0] + acc[ai][bj][m][n][1] + acc[ai][bj][m][n][2] + acc[ai][bj][m][n][3];
        if (t == 123.456f) *sink = t; }
};
struct MergeOrder {
    pg8::StaticOrder base;
    __device__ __forceinline__ bool next(int i, pg8::Unit& u) const { pg8::Unit t; if (!base.next(i >> 2, t)) return false; u.pm = t.pm; u.pn = (i & 3) * 4 + t.pn; return true; }
    __device__ __forceinline__ void a_ready(const pg8::Unit&) const {}
    __device__ __forceinline__ void done(const pg8::Unit&) const {}
};
struct EpiM {
    static constexpr bool PERM = true, AFTER_DRAIN = false;
    const bf16_t* G; bf16_t* mb; bf16_t* ps;
    __device__ __forceinline__ void operator()(const f32x4 (&acc)[2][2][4][2], const pg8::Unit& u, int wr, int wc, int fr, int fq) const {
        const int br = u.pn >> 2;
        const int row0 = u.pm * 256 + wr * 64 + fr; const int col0 = (u.pn & 3) * 256 + wc * 32 + 8 * fq;
#pragma unroll
        for (int ai = 0; ai < 2; ++ai) {
            u32x4 gq[4][2], mq[4][2];
#pragma unroll
            for (int m = 0; m < 4; ++m)
#pragma unroll
                for (int bj = 0; bj < 2; ++bj) { const size_t r = (size_t)(row0 + ai * 128 + m * 16);
                    gq[m][bj] = __builtin_nontemporal_load((const u32x4*)(G + ((((size_t)(u.pm * 16 + u.pn) * 8 + wr * 4 + wc) * 16 + (ai * 8 + m * 2 + bj)) * 64 + fq * 16 + fr) * 8));
                    mq[m][bj] = (br > 0) ? *(const u32x4*)(ps + ((((size_t)(u.pm * 4 + (u.pn & 3)) * 8 + wr * 4 + wc) * 16 + (ai * 8 + m * 2 + bj)) * 64 + fq * 16 + fr) * 8) : (u32x4){0u, 0u, 0u, 0u}; }
#pragma unroll
            for (int m = 0; m < 4; ++m)
#pragma unroll
                for (int bj = 0; bj < 2; ++bj) { const size_t r = (size_t)(row0 + ai * 128 + m * 16);
                    float g[8], o[8]; unpack8(gq[m][bj], g); unpack8(mq[m][bj], o);
                    const f32x4 v0 = acc[ai][bj][m][0], v1 = acc[ai][bj][m][1];
                    u32x4 w; w.x = pk2(o[0] + g[0] * v0[0], o[1] + g[1] * v0[1]); w.y = pk2(o[2] + g[2] * v0[2], o[3] + g[3] * v0[3]);
                    w.z = pk2(o[4] + g[4] * v1[0], o[5] + g[5] * v1[1]); w.w = pk2(o[6] + g[6] * v1[2], o[7] + g[7] * v1[3]);
                    if (br < 3) *(u32x4*)(ps + ((((size_t)(u.pm * 4 + (u.pn & 3)) * 8 + wr * 4 + wc) * 16 + (ai * 8 + m * 2 + bj)) * 64 + fq * 16 + fr) * 8) = w;
                    else *(u32x4*)(mb + r * DM + col0 + bj * 128) = w; }
            asm volatile("" ::: "memory");
        }
    }
};
struct EpiOut {
    static constexpr bool PERM = true, AFTER_DRAIN = false;
    const float* xin; const float* xcin; float* xout; float* xcout; const float* mod;
    __device__ __forceinline__ void operator()(const f32x4 (&acc)[2][2][4][2], const pg8::Unit& u, int wr, int wc, int fr, int fq) const {
        const int pm = u.pm; const bool isctx = pm >= 64;
        const float* gate = mod + (isctx ? 8 : (pm >> 3)) * 3072 + 2048;
        const float* src = isctx ? xcin : xin; float* dst = isctx ? xcout : xout;
        const int row0 = (isctx ? (pm - 64) : pm) * 256 + wr * 64 + fr; const int col0 = u.pn * 256 + wc * 32 + 8 * fq;
#pragma unroll
        for (int bj = 0; bj < 2; ++bj)
#pragma unroll
            for (int ai = 0; ai < 2; ++ai) {
                const int c = col0 + bj * 128; const f32x4 gv0 = *(const f32x4*)(gate + c), gv1 = *(const f32x4*)(gate + c + 4);
                f32x4 xq[4][2];
#pragma unroll
                for (int m = 0; m < 4; ++m) { const float* p = src + (size_t)(row0 + ai * 128 + m * 16) * DM + c; xq[m][0] = *(const f32x4*)p; xq[m][1] = *(const f32x4*)(p + 4); }
#pragma unroll
                for (int m = 0; m < 4; ++m) { float* p = dst + (size_t)(row0 + ai * 128 + m * 16) * DM + c; *(f32x4*)p = xq[m][0] + gv0 * acc[ai][bj][m][0]; *(f32x4*)(p + 4) = xq[m][1] + gv1 * acc[ai][bj][m][1]; }
                asm volatile("" ::: "memory");
            }
    }
};

__device__ __forceinline__ void transpose_item(const float* W, int K, int N, bf16_t* WT, int k0, int n0, int drow0, LAS float* scr, int lane, bool hp = false) {
#pragma unroll 8
    for (int i = 0; i < 32; ++i) { const int kk = 2 * i + (lane >> 5); scr[kk * 33 + (lane & 31)] = W[(size_t)(k0 + kk) * N + n0 + (lane & 31)]; }
    LDS_WAIT();
    const int c = lane & 7;
#pragma unroll
    for (int j = 0; j < 4; ++j) { const int n = (lane >> 3) + 8 * j; const LAS float* s = scr + (8 * c) * 33 + n;
        u32x4 o; o.x = pk2(s[0 * 33], s[1 * 33]); o.y = pk2(s[2 * 33], s[3 * 33]); o.z = pk2(s[4 * 33], s[5 * 33]); o.w = pk2(s[6 * 33], s[7 * 33]);
        const int dn = hp ? (128 * (n >> 4) + (n & 15)) : n;
        *(u32x4*)(WT + (size_t)(drow0 + dn) * K + k0 + 8 * c) = o; }
    LDS_WAIT();
}
__device__ __forceinline__ void convert_weights(KA a, int l, lds_t* lds, int gw, int ngw, int wid, int lane, int item0, int it_lo, int it_hi) {
    LAS float* scr = (LAS float*)(lds + wid * 8704);
    bf16_t* WinT = (bf16_t*)(a->ws + WS_W); bf16_t* WbrT = (bf16_t*)(a->ws + WS_WBR); bf16_t* WoT = (bf16_t*)(a->ws + WS_WO);
    for (int it = it_lo + gw - item0; it < it_hi; it += ngw) {
        if (it < it_lo) continue;
        int r = it;
        if (r < 5504) { const int kb = r / 344, nb = r % 344; const int n0 = nb * 32; int d0 = n0; bool hp = false;
            if (n0 < 512) d0 = (n0 >> 7) * 256 + (n0 & 127); else if (n0 < 1024) d0 = ((n0 - 512) >> 7) * 256 + 128 + (n0 & 127);
            else if ((n0 >= 1536 && n0 < 2560) || (n0 >= 3584 && n0 < 4352) || (n0 >= 4864 && n0 < 5888)) {
                const int sc = n0 & 255; d0 = (n0 & ~255) + 32 * (sc >> 6) + 16 * ((sc >> 5) & 1); hp = true; }
            transpose_item(a->in[7] + (size_t)l * DM * INW, DM, INW, WinT, kb * 64, n0, d0, scr, lane, hp); continue; }
        r -= 5504;
        if (r < 1024) { const int br = r >> 8, rr = r & 255; transpose_item(a->in[25 + br] + (size_t)l * 512 * DM, 512, DM, WbrT + (size_t)br * DM * 512, (rr >> 5) * 64, (rr & 31) * 32, (rr & 31) * 32, scr, lane); continue; }
        r -= 1024;
        transpose_item(a->in[29] + (size_t)l * DM * DM, DM, DM, WoT, (r >> 5) * 64, (r & 31) * 32, (r & 31) * 32, scr, lane);
    }
}

__device__ __forceinline__ void norm_phase(const float* xin, const float* xcin, const float* g, const float* mod, bf16_t* hn, int gw, int ngw, int lane) {
    f32x4 v[4], vn[4];
    { const int row = gw; if (row < NTOK) { const float* xr = row >= NLAT ? xcin + (size_t)(row - NLAT) * DM : xin + (size_t)row * DM;
#pragma unroll
        for (int j = 0; j < 4; ++j) v[j] = ((const f32x4*)xr)[lane + 64 * j]; } }
    for (int row = gw; row < NTOK; row += ngw) {
        const bool isctx = row >= NLAT;
        const float* mb = mod + (isctx ? 8 : row / SEQ) * 3072;
        f32x4 gg[4], sh[4], sc[4];
#pragma unroll
        for (int j = 0; j < 4; ++j) { const int c = 4 * (lane + 64 * j); gg[j] = *(const f32x4*)(g + c); sh[j] = *(const f32x4*)(mb + c); sc[j] = *(const f32x4*)(mb + 1024 + c); }
        const int nrow = row + ngw;
        if (nrow < NTOK) { const float* xr = nrow >= NLAT ? xcin + (size_t)(nrow - NLAT) * DM : xin + (size_t)nrow * DM;
#pragma unroll
            for (int j = 0; j < 4; ++j) vn[j] = ((const f32x4*)xr)[lane + 64 * j]; }
        float ss = 0.f;
#pragma unroll
        for (int j = 0; j < 4; ++j) ss += (v[j].x * v[j].x + v[j].y * v[j].y) + (v[j].z * v[j].z + v[j].w * v[j].w);
        const float rstd = rsqrtf(wave_sum(ss) * (1.f / DM) + EPSN);
#pragma unroll
        for (int j = 0; j < 4; ++j) { const int c = 4 * (lane + 64 * j);
            const f32x4 y = v[j] * rstd * gg[j] * (sc[j] + 1.f) + sh[j];
            u32x2 o; o.x = pk2(y.x, y.y); o.y = pk2(y.z, y.w);
            *(u32x2*)(hn + (size_t)row * DM + c) = o; }
#pragma unroll
        for (int j = 0; j < 4; ++j) v[j] = vn[j];
    }
}

__device__ __forceinline__ void prep_phase(KA a, int l, lds_t* lds, int gw, int ngw, int wid, int lane, bool dry) {
    bf16_t* qkv = (bf16_t*)(a->ws + WS_QKV); bf16_t* vt = (bf16_t*)(a->ws + WS_VT);
    const float* rope = (const float*)(a->ws + WS_ROPE);
    const int j = lane & 7;
    for (int row = gw; row < NTOK; row += ngw) {
        const bool isctx = row >= NLAT; const int t = row & (SEQ - 1);
        bf16_t* rp = qkv + (size_t)row * QP;
        u32x4 raws[6];
#pragma unroll
        for (int it = 0; it < 6; ++it) { const int vr = it * 8 + (lane >> 3); const int v = vr < 42 ? vr : 41;
            const int col = v < 16 ? 512 + 64 * v : (v < 26 ? 2048 + 64 * (v - 16) : 2816 + 64 * (v - 26));
            raws[it] = *(const u32x4*)(rp + col + j * 8); }
#pragma unroll
        for (int it = 0; it < 6; ++it) {
            const int vr = it * 8 + (lane >> 3); const bool valid = vr < 42; const int v = valid ? vr : 41;
            const int col = v < 16 ? 512 + 64 * v : (v < 26 ? 2048 + 64 * (v - 16) : 2816 + 64 * (v - 26));
            const int gi = v < 8 ? 13 : (v < 16 ? 14 : (v < 24 ? 16 : (v < 26 ? 17 : (v < 34 ? 18 : 19))));
            const bool isq = (v < 8) || (v >= 16 && v < 24) || (v >= 26 && v < 34);
            const bool dorope = (v >= 16) && !isctx;
            const float* gp = a->in[gi] + l * 64 + j * 8;
            const u32x4 raw = raws[it];
            float x[8]; unpack8(raw, x);
            float ss = 0.f;
#pragma unroll
            for (int e = 0; e < 8; ++e) ss += x[e] * x[e];
            ss += __shfl_xor(ss, 1); ss += __shfl_xor(ss, 2); ss += __shfl_xor(ss, 4);
            const float rstd = rsqrtf(ss * (1.f / 64.f) + EPSN);
            const f32x4 g0 = *(const f32x4*)gp, g1 = *(const f32x4*)(gp + 4);
            float y[8] = {x[0] * rstd * g0.x, x[1] * rstd * g0.y, x[2] * rstd * g0.z, x[3] * rstd * g0.w, x[4] * rstd * g1.x, x[5] * rstd * g1.y, x[6] * rstd * g1.z, x[7] * rstd * g1.w};
            const int pos = (j < 4) ? (t >> 6) : (t & 63);
            const float* cp = rope + pos * 16 + 8 * (j & 1);
            const float sgn = (j & 2) ? 1.f : -1.f;
#pragma unroll
            for (int e = 0; e < 8; ++e) { const float p = __shfl_xor(y[e], 2); if (dorope) y[e] = y[e] * cp[e] + sgn * p * cp[1024 + e]; }
            const float qs = isq ? C2 : 1.f;
            u32x4 o; o.x = pk2(y[0] * qs, y[1] * qs); o.y = pk2(y[2] * qs, y[3] * qs); o.z = pk2(y[4] * qs, y[5] * qs); o.w = pk2(y[6] * qs, y[7] * qs);
            if (valid && !dry) *(u32x4*)(rp + col + j * 8) = o;
        }
    }
}

struct AttnP {
    const bf16_t* qkv; bf16_t* y; int vcol;
    int qrow, qcol, kcol, kcoff, ntile, nlat, lat_row0, lat_key0, ctx_row0, ycol;
    int qgr, kgr0, qc0; const float* rpb;
    float lam, oml; const float* subg;
};
__device__ __forceinline__ int crow(int r, int hi) { return (r & 3) + 8 * (r >> 2) + 4 * hi; }
constexpr int AT_VS0 = 34816, AT_WSF = 90112, AT_BIAS = 91136, AT_EO = 93184;

__device__ __forceinline__ float max3f(float a, float b, float c) { float r; asm("v_max3_f32 %0, %1, %2, %3" : "=v"(r) : "v"(a), "v"(b), "v"(c)); return r; }
constexpr float AT_THR = 6.0f;
template <int KW, int DV, int MODE, int VAR>
__device__ __forceinline__ void attn_tile(lds_t* lds, const AttnP& P, int t, int st, int l32, int hi, LAS float* wsf, const LAS float* biasl,
                                          const bf16x8 (&qf)[4], const unsigned (&bpk)[16], f32x16 (&O)[DV / 32], f32x16& negm, float& mrun, float& lrun) {
    constexpr int KP = KW * 2 + 16, VP = (DV == 64) ? 192 : 320, KSB = 64 * KP, VSB = 64 * VP, NDB = DV / 32;
    typedef float f32x2 __attribute__((ext_vector_type(2)));
    bool active = true; int dr = 0;
    if (MODE == 1 && t < P.nlat) { const int kr = P.kgr0 + t; int r0 = P.qgr - 4; r0 = r0 < 0 ? 0 : (r0 > 24 ? 24 : r0); active = (kr >= r0) && (kr < r0 + 8); dr = kr - P.qgr + 7; }
    if (!active) return;
    constexpr bool VHOIST = (MODE != 2) && (VAR != 2);
    typedef short v4i16h_t __attribute__((ext_vector_type(4)));
    bf16x8 vh[2][4];
    if (VHOIST) {
        const lds_t* vb0 = lds + AT_VS0 + st * (64 * ((DV == 64) ? 192 : 320)) + (4 * hi + ((l32 & 15) >> 2)) * ((DV == 64) ? 192 : 320) + (16 * (l32 >> 4) + 4 * (l32 & 3)) * 2;
#pragma unroll
        for (int d2 = 0; d2 < 2; ++d2)
#pragma unroll
            for (int kj = 0; kj < 4; ++kj) {
                const lds_t* ap = vb0 + kj * 16 * ((DV == 64) ? 192 : 320) + d2 * 64;
                const s16x4 lo = __builtin_bit_cast(s16x4, __builtin_amdgcn_ds_read_tr16_b64_v4i16((LAS v4i16h_t*)ap));
                const s16x4 hh = __builtin_bit_cast(s16x4, __builtin_amdgcn_ds_read_tr16_b64_v4i16((LAS v4i16h_t*)(ap + 8 * ((DV == 64) ? 192 : 320))));
                vh[d2][kj] = (bf16x8){lo[0], lo[1], lo[2], lo[3], hh[0], hh[1], hh[2], hh[3]};
            }
    }
    const lds_t* kb_ = lds + st * KSB + l32 * KP + P.kcoff * 2 + hi * 16;
    f32x16 s0, s1;
    if (VAR == 3) {
#pragma unroll
        for (int r = 0; r < 16; ++r) { s0[r] = (float)(t + r) * 1e-3f; s1[r] = (float)(t - r) * 1e-3f; }
    } else {
        bf16x8 kf[8];
#pragma unroll
        for (int d = 0; d < 4; ++d) { kf[2 * d] = *(const LAS bf16x8*)(kb_ + d * 32); kf[2 * d + 1] = *(const LAS bf16x8*)(kb_ + 32 * KP + d * 32); }
        asm volatile("" ::: "memory");
        __builtin_amdgcn_s_setprio(1);
#pragma unroll
        for (int d = 0; d < 4; ++d) {
            if (d == 0) { s0 = __builtin_amdgcn_mfma_f32_32x32x16_bf16(kf[0], qf[0], negm, 0, 0, 0); s1 = __builtin_amdgcn_mfma_f32_32x32x16_bf16(kf[1], qf[0], negm, 0, 0, 0); }
            else { s0 = __builtin_amdgcn_mfma_f32_32x32x16_bf16(kf[2 * d], qf[d], s0, 0, 0, 0); s1 = __builtin_amdgcn_mfma_f32_32x32x16_bf16(kf[2 * d + 1], qf[d], s1, 0, 0, 0); }
        }
        __builtin_amdgcn_s_setprio(0);
    }
    if (MODE == 1 && t < P.nlat) {
        const LAS unsigned char* brow = (const LAS unsigned char*)(biasl + dr * 32);
#pragma unroll
        for (int r = 0; r < 16; ++r) { s0[r] += *(const LAS float*)(brow + (bpk[r] & 0xffffu)); s1[r] += *(const LAS float*)(brow + (bpk[r] >> 16)); }
    }
    if (VAR != 1) {
        float ma = max3f(s0[0], s0[1], s0[2]), mb = max3f(s0[3], s0[4], s0[5]), mc = max3f(s1[0], s1[1], s1[2]), md = max3f(s1[3], s1[4], s1[5]);
        ma = max3f(ma, s0[6], s0[7]); mb = max3f(mb, s0[8], s0[9]); ma = max3f(ma, s0[10], s0[11]); mb = max3f(mb, s0[12], s0[13]); ma = max3f(ma, s0[14], s0[15]);
        mc = max3f(mc, s1[6], s1[7]); md = max3f(md, s1[8], s1[9]); mc = max3f(mc, s1[10], s1[11]); md = max3f(md, s1[12], s1[13]); mc = max3f(mc, s1[14], s1[15]);
        float mx = max3f(ma, mb, mc); mx = fmaxf(mx, md);
        const bool fresh = (lrun == 0.f);
        if (__any(fresh || mx > AT_THR)) {
            mx = fmaxf(mx, __shfl_xor(mx, 32));
            const float dl = fresh ? mx : fmaxf(mx, 0.f);
            const float alpha = fresh ? 1.f : fexp2(-dl);
            mrun += dl; lrun *= alpha;
#pragma unroll
            for (int r = 0; r < 16; ++r) { s0[r] -= dl; s1[r] -= dl; negm[r] = -mrun; }
            if (hi == 0) wsf[l32] = alpha;
            LDS_WAIT();
            float av[16];
#pragma unroll
            for (int j = 0; j < 4; ++j) { const f32x4 a4 = *(const LAS f32x4*)(wsf + 8 * j + 4 * hi); av[4 * j] = a4.x; av[4 * j + 1] = a4.y; av[4 * j + 2] = a4.z; av[4 * j + 3] = a4.w; }
#pragma unroll
            for (int db = 0; db < NDB; ++db)
#pragma unroll
                for (int r = 0; r < 16; ++r) O[db][r] *= av[r];
            LDS_WAIT();
        }
#pragma unroll
        for (int r = 0; r < 16; ++r) { s0[r] = fexp2(s0[r]); s1[r] = fexp2(s1[r]); }
    }
    f32x2 lsa = {s0[0], s1[0]}, lsb = {s0[1], s1[1]}, lsc = {s0[2], s1[2]}, lsd = {s0[3], s1[3]};
#pragma unroll
    for (int r = 4; r < 16; r += 4) { lsa += (f32x2){s0[r], s1[r]}; lsb += (f32x2){s0[r + 1], s1[r + 1]}; lsc += (f32x2){s0[r + 2], s1[r + 2]}; lsd += (f32x2){s0[r + 3], s1[r + 3]}; }
    lsa += lsb; lsc += lsd; lsa += lsc;
    lrun += lsa.x + lsa.y;
    bf16x8 pa[4];
#pragma unroll
    for (int jj = 0; jj < 2; ++jj) {
        u32x4 w0, w1;
        w0.x = pk2(s0[8 * jj + 0], s0[8 * jj + 1]); w0.y = pk2(s0[8 * jj + 2], s0[8 * jj + 3]); w0.z = pk2(s0[8 * jj + 4], s0[8 * jj + 5]); w0.w = pk2(s0[8 * jj + 6], s0[8 * jj + 7]);
        w1.x = pk2(s1[8 * jj + 0], s1[8 * jj + 1]); w1.y = pk2(s1[8 * jj + 2], s1[8 * jj + 3]); w1.z = pk2(s1[8 * jj + 4], s1[8 * jj + 5]); w1.w = pk2(s1[8 * jj + 6], s1[8 * jj + 7]);
        pa[jj] = __builtin_bit_cast(bf16x8, w0); pa[2 + jj] = __builtin_bit_cast(bf16x8, w1);
    }
    const lds_t* vb_ = lds + AT_VS0 + st * VSB + (4 * hi + ((l32 & 15) >> 2)) * VP + (16 * (l32 >> 4) + 4 * (l32 & 3)) * 2;
#pragma unroll
    for (int dh = 0; dh < NDB; dh += 2) {
        typedef short v4i16_t __attribute__((ext_vector_type(4)));
        bf16x8 vfr[2][4];
        if (VHOIST) {
#pragma unroll
            for (int d2 = 0; d2 < 2; ++d2)
#pragma unroll
                for (int kj = 0; kj < 4; ++kj) vfr[d2][kj] = vh[d2][kj];
        } else if (VAR != 2) {
#pragma unroll
            for (int d2 = 0; d2 < 2; ++d2)
#pragma unroll
                for (int kj = 0; kj < 4; ++kj) {
                    const lds_t* ap = vb_ + kj * 16 * VP + (dh + d2) * 64;
                    const s16x4 lo = __builtin_bit_cast(s16x4, __builtin_amdgcn_ds_read_tr16_b64_v4i16((LAS v4i16_t*)ap));
                    const s16x4 hh = __builtin_bit_cast(s16x4, __builtin_amdgcn_ds_read_tr16_b64_v4i16((LAS v4i16_t*)(ap + 8 * VP)));
                    vfr[d2][kj] = (bf16x8){lo[0], lo[1], lo[2], lo[3], hh[0], hh[1], hh[2], hh[3]};
                }
            asm volatile("" ::: "memory");
        }
#pragma unroll
        for (int kj = 0; kj < 4; ++kj)
#pragma unroll
            for (int d2 = 0; d2 < 2; ++d2) {
                const int db = dh + d2;
                if (VAR == 2) { O[db][kj] += (float)pa[kj][0] + (float)pa[kj][1] + (float)pa[kj][2] + (float)pa[kj][3] + (float)pa[kj][4] + (float)pa[kj][5] + (float)pa[kj][6] + (float)pa[kj][7]; continue; }
                O[db] = __builtin_amdgcn_mfma_f32_32x32x16_bf16(pa[kj], vfr[d2][kj], O[db], 0, 0, 0);
            }
    }
}

template <int KW, int DV, int MODE, int VAR>
__device__ __forceinline__ void attn_unit(lds_t* lds, const AttnP& P, bool dry) {
    constexpr int KP = KW * 2 + 16, VP = (DV == 64) ? 192 : 320, KSB = 64 * KP, VSB = 64 * VP, NDB = DV / 32, NKR = KW / 64, NVR = DV / 64;
    const int tid = opaque_tid(), lane = tid & 63, wid = __builtin_amdgcn_readfirstlane(tid >> 6), l32 = lane & 31, hi = lane >> 5;
    LAS float* wsf = (LAS float*)(lds + AT_WSF) + wid * 32;
    LAS float* biasl = (LAS float*)(lds + AT_BIAS);
    unsigned bpk[16];
#pragma unroll
    for (int r = 0; r < 16; ++r) bpk[r] = 0u;
    if (MODE == 1) {
        for (int i = tid; i < 15 * 32; i += 512) { const int d = i >> 5, c = i & 31; biasl[i] = (c < 31) ? P.rpb[d * 31 + c] * LOG2E : -1e30f; }
        const int qc = P.qc0 + l32; int c0 = qc - 8; c0 = c0 < 0 ? 0 : (c0 > 48 ? 48 : c0);
#pragma unroll
        for (int r = 0; r < 16; ++r) { const int kc0 = crow(r, hi), kc1 = 32 + kc0;
            const unsigned i0 = ((unsigned)(kc0 - c0) < 16u) ? (unsigned)(kc0 - qc + 15) : 31u, i1 = ((unsigned)(kc1 - c0) < 16u) ? (unsigned)(kc1 - qc + 15) : 31u;
            bpk[r] = (i0 * 4u) | ((i1 * 4u) << 16); }
    }
    bf16x8 qf[4];
    { const bf16_t* qp = P.qkv + (size_t)(P.qrow + l32) * QP + P.qcol + hi * 8;
#pragma unroll
      for (int d = 0; d < 4; ++d) qf[d] = *(const bf16x8*)(qp + d * 16); }
    f32x16 O[NDB];
#pragma unroll
    for (int db = 0; db < NDB; ++db)
#pragma unroll
        for (int r = 0; r < 16; ++r) O[db][r] = 0.f;
    float mrun = 0.f, lrun = 0.f;
    f32x16 negm;
#pragma unroll
    for (int r = 0; r < 16; ++r) negm[r] = 0.f;
    u32x4 kA[NKR], vA[NVR], kB[NKR], vB[NVR];
    const int nt = (VAR == 6) ? 1 : P.ntile;
#define AT_LOAD(t_, kreg, vreg) do { const int t__ = (t_); const int krow_ = t__ < P.nlat ? P.lat_row0 + 64 * t__ : P.ctx_row0 + 64 * (t__ - P.nlat); const int vkey_ = t__ < P.nlat ? P.lat_key0 + 64 * t__ : SEQ + 64 * (t__ - P.nlat); \
        _Pragma("unroll") for (int i_ = 0; i_ < NKR; ++i_) { const int c_ = tid + 512 * i_; const int r_ = c_ / (KW / 8), ch_ = c_ % (KW / 8); kreg[i_] = *(const u32x4*)(P.qkv + (size_t)(krow_ + r_) * QP + P.kcol + ch_ * 8); } \
        _Pragma("unroll") for (int i_ = 0; i_ < NVR; ++i_) { const int c_ = tid + 512 * i_; const int r_ = c_ / (DV / 8), ch_ = c_ % (DV / 8); vreg[i_] = *(const u32x4*)(P.qkv + (size_t)(krow_ + r_) * QP + P.vcol + ch_ * 8); } } while (0)
#define AT_STORE(st_, kreg, vreg) do { \
        _Pragma("unroll") for (int i_ = 0; i_ < NKR; ++i_) { const int c_ = tid + 512 * i_; const int r_ = c_ / (KW / 8), ch_ = c_ % (KW / 8); *(LAS u32x4*)(lds + (st_) * KSB + r_ * KP + ch_ * 16) = kreg[i_]; } \
        _Pragma("unroll") for (int i_ = 0; i_ < NVR; ++i_) { const int c_ = tid + 512 * i_; const int r_ = c_ / (DV / 8), ch_ = c_ % (DV / 8); *(LAS u32x4*)(lds + AT_VS0 + (st_) * VSB + r_ * VP + ch_ * 16) = vreg[i_]; } } while (0)
#define AT_BAR0() asm volatile("s_waitcnt lgkmcnt(0)\n\ts_barrier" ::: "memory")
#define AT_BAR() do { if (VAR != 5) AT_BAR0(); } while (0)
    AT_LOAD(0, kA, vA); AT_STORE(0, kA, vA);
    if (nt > 1) AT_LOAD(1, kB, vB);
    AT_BAR0();
    for (int t = 0; t < nt; t += 2) {
        if (VAR != 4 && t + 2 < nt) AT_LOAD(t + 2, kA, vA);
        attn_tile<KW, DV, MODE, VAR>(lds, P, t, 0, l32, hi, wsf, biasl, qf, bpk, O, negm, mrun, lrun);
        if (t + 1 < nt) AT_STORE(1, kB, vB);
        AT_BAR();
        if (t + 1 < nt) {
            if (VAR != 4 && t + 3 < nt) AT_LOAD(t + 3, kB, vB);
            attn_tile<KW, DV, MODE, VAR>(lds, P, t + 1, 1, l32, hi, wsf, biasl, qf, bpk, O, negm, mrun, lrun);
            if (t + 2 < nt) AT_STORE(0, kA, vA);
            AT_BAR();
        }
    }
    if (VAR == 5) asm volatile("s_waitcnt lgkmcnt(0)\n\ts_barrier" ::: "memory");
#undef AT_LOAD
#undef AT_STORE
#undef AT_BAR
#undef AT_BAR0
    const float lt = lrun + __shfl_xor(lrun, 32);
    if (hi == 0) wsf[l32] = 1.f / lt;
    LDS_WAIT();
    float av[16];
#pragma unroll
    for (int j = 0; j < 4; ++j) { const f32x4 a4 = *(const LAS f32x4*)(wsf + 8 * j + 4 * hi); av[4 * j] = a4.x; av[4 * j + 1] = a4.y; av[4 * j + 2] = a4.z; av[4 * j + 3] = a4.w; }
    LDS_WAIT();
    if (MODE != 2) {
        static_assert(MODE == 2 || DV == 64, "row-staged epilogue is written for 64-wide heads");
        lds_t* eo = lds + AT_EO + wid * 4608;
        u32x4 gq[4];
#pragma unroll
        for (int i = 0; i < 4; ++i) { const int c = lane + 64 * i; gq[i] = *(const u32x4*)(P.y + (size_t)(P.qrow + (c >> 3)) * YP + P.ycol + (c & 7) * 8); }
#pragma unroll
        for (int db = 0; db < NDB; ++db)
#pragma unroll
            for (int r = 0; r < 16; ++r) *(LAS bf16_t*)(eo + crow(r, hi) * 144 + (db * 32 + l32) * 2) = (bf16_t)f2bf(O[db][r] * av[r]);
        LDS_WAIT();
#pragma unroll
        for (int i = 0; i < 4; ++i) { const int c = lane + 64 * i;
            const u32x4 ow = *(const LAS u32x4*)(eo + (c >> 3) * 144 + (c & 7) * 16);
            float o[8], g[8]; unpack8(ow, o); unpack8(gq[i], g);
            u32x4 w; w.x = pk2(o[0] * silu(g[0]), o[1] * silu(g[1])); w.y = pk2(o[2] * silu(g[2]), o[3] * silu(g[3])); w.z = pk2(o[4] * silu(g[4]), o[5] * silu(g[5])); w.w = pk2(o[6] * silu(g[6]), o[7] * silu(g[7]));
            if (!dry) *(u32x4*)(P.y + (size_t)(P.qrow + (c >> 3)) * YP + P.ycol + (c & 7) * 8) = w; }
        LDS_WAIT();
    } else {
        LAS float* X = (LAS float*)lds;
        const int qs = 32 * (wid & 3);
        if (wid >= 4) {
#pragma unroll
            for (int db = 0; db < NDB; ++db)
#pragma unroll
                for (int r = 0; r < 16; ++r) X[(qs + crow(r, hi)) * 132 + db * 32 + l32] = O[db][r] * av[r];
        }
        __syncthreads();
        if (wid < 4) {
            lds_t* eo = lds + AT_EO + wid * 8704;
            u32x4 gq[8];
#pragma unroll
            for (int i = 0; i < 8; ++i) { const int c = lane + 64 * i; gq[i] = *(const u32x4*)(P.y + (size_t)(P.qrow + (c >> 4)) * YP + P.ycol + (c & 15) * 8); }
            float ssq[16];
#pragma unroll
            for (int r = 0; r < 16; ++r) ssq[r] = 0.f;
#pragma unroll
            for (int db = 0; db < NDB; ++db)
#pragma unroll
                for (int r = 0; r < 16; ++r) { const float o = O[db][r] * av[r] - P.lam * X[(qs + crow(r, hi)) * 132 + db * 32 + l32]; O[db][r] = o; ssq[r] += o * o; }
#pragma unroll
            for (int r = 0; r < 16; ++r) { float s = ssq[r]; s += __shfl_xor(s, 1); s += __shfl_xor(s, 2); s += __shfl_xor(s, 4); s += __shfl_xor(s, 8); s += __shfl_xor(s, 16); ssq[r] = rsqrtf(s * (1.f / 128.f) + EPSN) * P.oml; }
#pragma unroll
            for (int db = 0; db < NDB; ++db) {
                const float sg = P.subg[db * 32 + l32];
#pragma unroll
                for (int r = 0; r < 16; ++r) *(LAS bf16_t*)(eo + crow(r, hi) * 272 + (db * 32 + l32) * 2) = (bf16_t)f2bf(O[db][r] * ssq[r] * sg);
            }
            LDS_WAIT();
#pragma unroll
            for (int i = 0; i < 8; ++i) { const int c = lane + 64 * i;
                const u32x4 ow = *(const LAS u32x4*)(eo + (c >> 4) * 272 + (c & 15) * 16);
                float o[8], g[8]; unpack8(ow, o); unpack8(gq[i], g);
                u32x4 w; w.x = pk2(o[0] * silu(g[0]), o[1] * silu(g[1])); w.y = pk2(o[2] * silu(g[2]), o[3] * silu(g[3])); w.z = pk2(o[4] * silu(g[4]), o[5] * silu(g[5])); w.w = pk2(o[6] * silu(g[6]), o[7] * silu(g[7]));
                if (!dry) *(u32x4*)(P.y + (size_t)(P.qrow + (c >> 4)) * YP + P.ycol + (c & 15) * 8) = w; }
            LDS_WAIT();
        }
        __syncthreads();
    }
}

__device__ __forceinline__ void conv_unit(lds_t* lds, KA a, int l, int row0, int seqlen, int t0, bool dry) {
    const int tid = opaque_tid(), lane = tid & 63, wid = tid >> 6, c = tid;
    const bf16_t* qkv = (const bf16_t*)(a->ws + WS_QKV); bf16_t* Y = (bf16_t*)(a->ws + WS_Y);
#pragma unroll
    for (int i = 0; i < 8; ++i) { const int idx = tid + 512 * i;
        if (idx < 62 * 64) { const int r = idx >> 6, ch = idx & 63; const int tt = t0 - 15 + r;
            u32x4 v = {0u, 0u, 0u, 0u};
            if (tt >= 0 && tt < seqlen) v = *(const u32x4*)(qkv + (size_t)(row0 + tt) * QP + ch * 8);
            *(LAS u32x4*)(lds + r * 1024 + ch * 16) = v; } }
    float w[31];
#pragma unroll
    for (int k = 0; k < 31; ++k) w[k] = a->in[9][(size_t)(l * 31 + k) * 512 + c];
    const float cb = a->in[10][l * 512 + c], lg = a->in[11][l * 512 + c], lb = a->in[12][l * 512 + c];
    __syncthreads();
    float hv[62];
#pragma unroll
    for (int r = 0; r < 62; ++r) hv[r] = bf2f(*(const LAS bf16_t*)(lds + r * 1024 + c * 2));
    float v[32];
#pragma unroll
    for (int t = 0; t < 32; ++t) { float acc = cb;
#pragma unroll
        for (int k = 0; k < 31; ++k) acc += w[k] * hv[t + k];
        v[t] = acc; }
    __syncthreads();
    LAS float* vb = (LAS float*)lds; LAS float* stats = (LAS float*)(lds + 65536);
#pragma unroll
    for (int t = 0; t < 32; ++t) vb[t * 512 + c] = v[t];
    __syncthreads();
#pragma unroll
    for (int q = 0; q < 4; ++q) { const int t = wid * 4 + q; float xs[8]; float s = 0.f;
#pragma unroll
        for (int i = 0; i < 8; ++i) { xs[i] = vb[t * 512 + lane + 64 * i]; s += xs[i]; }
        const float mean = wave_sum(s) * (1.f / 512.f); float q2 = 0.f;
#pragma unroll
        for (int i = 0; i < 8; ++i) { const float d = xs[i] - mean; q2 += d * d; }
        const float rstd = rsqrtf(wave_sum(q2) * (1.f / 512.f) + EPSN);
        if (lane == 0) { stats[2 * t] = mean; stats[2 * t + 1] = rstd; } }
    __syncthreads();
    bf16_t gtc[32];
#pragma unroll
    for (int t = 0; t < 32; ++t) gtc[t] = Y[(size_t)(row0 + t0 + t) * YP + c];
#pragma unroll
    for (int t = 0; t < 32; ++t) {
        const float yn = (v[t] - stats[2 * t]) * stats[2 * t + 1] * lg + lb;
        bf16_t* yp = Y + (size_t)(row0 + t0 + t) * YP + c;
        const float g = bf2f(gtc[t]);
        if (!dry) *yp = (bf16_t)f2bf(silu(yn) * silu(g));
    }
    __syncthreads();
}

template <int KM, int VAR> __device__ __forceinline__ void mix_phase(lds_t* lds, KA a, int l, bool dry) {
    const int wid = __builtin_amdgcn_readfirstlane(opaque_tid() >> 6);
    const int nunit = (l == 0) ? 2304 : 2048;
    const float lam_init = (l == 0) ? 0.2f : (0.8f - 0.6f * 0.7408182206817179f);
    AttnP P; P.qkv = (const bf16_t*)(a->ws + WS_QKV); P.y = (bf16_t*)(a->ws + WS_Y);
    P.lam = ((const float*)(a->ws + WS_LAM))[l]; P.oml = 1.f - lam_init; P.subg = a->in[24] + l * 128;
    P.qgr = 0; P.kgr0 = 0; P.qc0 = 0; P.rpb = a->in[15]; P.kcoff = 0;
    const bool remap = gridDim.x == 256; const int xcd = blockIdx.x & 7, slot = blockIdx.x >> 3;
    for (int ui = blockIdx.x; ui < nunit; ui += gridDim.x) {
        int kind, cv_row0 = 0, cv_len = SEQ, cv_t0 = 0;
        P.kcoff = 0; P.nlat = 32; P.ntile = 36; P.lat_key0 = 0;
        if (ui < 512 || (ui >= 2112 && ui < 2176)) {
            const bool cx = ui >= 512; const int u = cx ? ui - 2112 : (remap ? (((ui >> 8) * 16 + 2 * xcd + (slot >> 4)) * 16 + (slot & 15)) : ui);
            const int b = cx ? (u >> 3) : (u >> 6), h = cx ? ((u >> 1) & 3) : ((u >> 4) & 3), qb = cx ? (u & 1) : (u & 15), t = wid >> 2;
            kind = 2;
            P.qrow = (cx ? NLAT + b * CTXL : b * SEQ) + qb * 128 + 32 * (wid & 3); P.qcol = 2816 + (2 * h + t) * 64; P.kcol = 3328 + 128 * h; P.kcoff = 64 * t;
            P.vcol = 3840 + 128 * h; P.lat_row0 = b * SEQ; P.ctx_row0 = NLAT + b * CTXL; P.ycol = 1536 + 128 * h;
            if (cx) { P.nlat = 0; P.ntile = 4; }
        } else if (ui < 1024) {
            const int u = remap ? ((((ui - 512) >> 8) * 8 + xcd) * 32 + slot) : ui - 512; const int b = u >> 6, n = (u >> 5) & 1, qb = u & 31, hq = 4 * n + (wid >> 1);
            kind = 0;
            P.qrow = b * SEQ + qb * 64 + 32 * (wid & 1); P.qcol = 2048 + 64 * hq; P.kcol = 2560 + 64 * n;
            P.vcol = 2688 + 64 * n; P.lat_row0 = b * SEQ; P.ctx_row0 = NLAT + b * CTXL; P.ycol = 1024 + 64 * hq;
        } else if (ui < 1536) {
            const int u = remap ? ((((ui - 1024) >> 8) * 32 + 4 * xcd + (slot >> 3)) * 8 + ((slot + 4 * ((ui - 1024) >> 8)) & 7)) : ui - 1024; const int b = u >> 6, h = (u >> 3) & 7, rg = u & 7;
            int k0 = 4 * rg - 4; k0 = k0 < 0 ? 0 : (k0 > 24 ? 24 : k0); int k1 = 4 * rg + 3 - 4; k1 = k1 < 0 ? 0 : (k1 > 24 ? 24 : k1);
            kind = 1;
            P.qgr = 4 * rg + (wid >> 1); P.qc0 = 32 * (wid & 1); P.kgr0 = k0; P.rpb = a->in[15] + (size_t)(l * 8 + h) * 465;
            P.qrow = b * SEQ + P.qgr * 64 + P.qc0; P.qcol = 512 + 64 * h; P.kcol = 1024 + 64 * h;
            P.vcol = 1536 + 64 * h; P.nlat = k1 + 8 - k0; P.ntile = P.nlat + 4; P.lat_row0 = b * SEQ + k0 * 64; P.lat_key0 = k0 * 64; P.ctx_row0 = NLAT + b * CTXL; P.ycol = 512 + 64 * h;
        } else if (ui < 2048) {
            const int u = ui - 1536; kind = 3; cv_row0 = (u >> 6) * SEQ; cv_len = SEQ; cv_t0 = (u & 63) * 32;
        } else if (ui < 2112) {
            const int u = ui - 2048; kind = 3; cv_row0 = NLAT + (u >> 3) * CTXL; cv_len = CTXL; cv_t0 = (u & 7) * 32;
        } else {
            const bool isb = ui >= 2240; const int u = isb ? ui - 2240 : ui - 2176; const int b = u >> 3, hq = u & 7, n = hq >> 2;
            kind = 0;
            P.qrow = NLAT + b * CTXL + 32 * wid; P.nlat = 0; P.ntile = 4; P.lat_row0 = 0; P.ctx_row0 = NLAT + b * CTXL;
            if (isb) { P.qcol = 512 + 64 * hq; P.kcol = 1024 + 64 * hq; P.vcol = 1536 + 64 * hq; P.ycol = 512 + 64 * hq; }
            else { P.qcol = 2048 + 64 * hq; P.kcol = 2560 + 64 * n; P.vcol = 2688 + 64 * n; P.ycol = 1024 + 64 * hq; }
        }
        if ((KM & 1) && kind == 0) attn_unit<64, 64, 0, VAR>(lds, P, dry);
        if ((KM & 2) && kind == 1) attn_unit<64, 64, 1, VAR>(lds, P, dry);
        if ((KM & 4) && kind == 2) attn_unit<128, 128, 2, VAR>(lds, P, dry);
        if ((KM & 8) && kind == 3) conv_unit(lds, a, l, cv_row0, cv_len, cv_t0, dry);
    }
}

template <int J> __device__ __forceinline__ void run_phases(lds_t* lds) {
    cg::grid_group grid = cg::this_grid();
    int lo, hi; { KA a = get_args(); lo = a->ph_lo; hi = a->ph_hi; }
    { LAS float* ropeL = (LAS float*)(lds + AT_ROPE);
      for (int idx = threadIdx.x; idx < 1024; idx += 512) { const int pos = idx >> 4, i = idx & 15; const float ang = (float)pos * exp2f(-(float)i * (13.287712379549449f / 16.f)); ropeL[idx] = cosf(ang); ropeL[1024 + idx] = sinf(ang); }
      __syncthreads(); }
    XcdBarrier bar; bar.bar = nullptr; bar.x = 0; bar.st = nullptr;
    if (J < 0) {
        volatile LAS unsigned* st = (volatile LAS unsigned*)(lds + 131328);
        if (threadIdx.x < 2) st[threadIdx.x] = 0u;
        __syncthreads();
        KA a = get_args(); bar = xcd_barrier_post((unsigned*)(a->ws + WS_BAR), st);
        if (hi > 1000) grid.sync();
    }
#define KIND(j) (J < 0 || J == (j) || ((j) == 4 && J >= 40))
#define IN(k) (lo <= (k) && (k) < hi)
#define SEAM(k) do { if (J < 0) { if (IN(k) && IN((k) + 1)) { PROBE_LOOP(99) xcd_barrier(bar); } } } while (0)
#define WAVEIDS() const int tid = opaque_tid(), lane = tid & 63, wid = __builtin_amdgcn_readfirstlane(tid >> 6); const int G = gridDim.x, gw = blockIdx.x * 8 + wid, ngw = G * 8; (void)lane; (void)gw; (void)ngw; (void)G

    if (KIND(0) && IN(0)) PROBE_LOOP(0) {
        KA a = get_args(); WAVEIDS();
        float* mod = (float*)(a->ws + WS_MOD);
        LAS float* cs = (LAS float*)(lds + 73728);
        for (int i = tid; i < 9 * 1024; i += 512) { const float v = (i < 8192) ? a->in[1][i] : a->in[3][i - 8192]; cs[i] = silu(v); }
        __syncthreads();
        for (int it = gw; it < 769; it += ngw) {
            if (it < 768) {
                const int l = it / 384, n0 = (it % 384) * 8, col = n0 + (lane & 7), kg = lane >> 3;
                float acc[9];
#pragma unroll
                for (int r = 0; r < 9; ++r) acc[r] = 0.f;
                const float* w = a->in[4] + (size_t)l * DM * 3072 + col;
#pragma unroll 8
                for (int k = kg * 128; k < kg * 128 + 128; ++k) { const float wv = w[(size_t)k * 3072];
#pragma unroll
                    for (int r = 0; r < 9; ++r) acc[r] += cs[r * 1024 + k] * wv; }
#pragma unroll
                for (int r = 0; r < 9; ++r) { acc[r] += __shfl_xor(acc[r], 8); acc[r] += __shfl_xor(acc[r], 16); acc[r] += __shfl_xor(acc[r], 32); }
                if (lane < 8) {
                    const float bb = a->in[5][l * 3072 + col];
#pragma unroll
                    for (int r = 0; r < 9; ++r) mod[(size_t)(l * 9 + r) * 3072 + col] = acc[r] + bb; }
            } else {
                if (lane < 2) { const int l = lane; float s1 = 0.f, s2 = 0.f;
                    for (int e = 0; e < 64; ++e) { s1 += a->in[20][l * 64 + e] * a->in[21][l * 64 + e]; s2 += a->in[22][l * 64 + e] * a->in[23][l * 64 + e]; }
                    const float li = (l == 0) ? 0.2f : (0.8f - 0.6f * 0.7408182206817179f);
                    ((float*)(a->ws + WS_LAM))[l] = expf(s1) - expf(s2) + li; }
            }
        }
        convert_weights(a, 0, lds, gw, ngw, wid, lane, 769, 0, 7040);
    }
    SEAM(0);
#pragma unroll 1
    for (int L = 0; L < 2; ++L) {
        const int pb = 1 + 7 * L;
        if (KIND(1) && IN(pb + 0)) PROBE_LOOP(1) {
            KA a = get_args(); WAVEIDS();
            if (L == 1) convert_weights(a, 1, lds, gw, ngw, wid, lane, 0, (J < 0 && G == 256) ? 6528 : 0, 7040);
            norm_phase((L == 0) ? a->in[0] : a->out, (L == 0) ? a->in[2] : (const float*)(a->ws + WS_XC1), a->in[6] + L * DM, (const float*)(a->ws + WS_MOD) + (size_t)L * 9 * 3072, (bf16_t*)(a->ws + WS_HN), gw, ngw, lane);
        }
        SEAM(pb + 0);
        if (KIND(2) && IN(pb + 1)) PROBE_LOOP(2) {
            KA a = get_args();
            pg8::Gemm g{(const bf16_t*)(a->ws + WS_HN), (const bf16_t*)(a->ws + WS_W), NTOK, N1A, DM, DM, 0}; pg8::StaticOrder S; S.init(NTOK, N1A, (int)gridDim.x, (int)blockIdx.x);
            Epi1a E{(bf16_t*)(a->ws + WS_QKV), (bf16_t*)(a->ws + WS_Y), L, lds};
            pg8::gemm_phase<Epi1a, pg8::StaticOrder, true, true>(lds, g, S, E);
        }
        SEAM(pb + 1);
        if (KIND(4) && IN(pb + 3)) { { KA a = get_args(); mix_phase<(J < 0) ? 15 : (J >= 40 ? (1 << (J - 40)) : 15), 0>(lds, a, L, false); }
            if (PROBE_KIND >= 40 && PROBE_KIND <= 44) { _Pragma("unroll 1") for (int rep_ = 0; rep_ < PROBE_REP; ++rep_) { KA a = get_args(); mix_phase<(PROBE_KIND >= 40 && PROBE_KIND < 44) ? (1 << (PROBE_KIND - 40)) : 15, PROBE_VAR>(lds, a, L, a->ph_hi < 1000); } } }
        SEAM(pb + 3);
        const int Mmrg = (L == 0) ? NTOK : NLAT;
        if (KIND(5) && IN(pb + 4)) PROBE_LOOP(5) {
            KA a = get_args();
            pg8::Gemm g{(const bf16_t*)(a->ws + WS_HN), (const bf16_t*)(a->ws + WS_W) + (size_t)N1A * DM, Mmrg, NLOG, DM, DM, 0}; pg8::StaticOrder S; S.init(Mmrg, NLOG, (int)gridDim.x, (int)blockIdx.x);
            Epi1b E{(bf16_t*)(a->ws + WS_QKV), a->in[8] + L * NLOG};
            pg8::gemm_phase<Epi1b, pg8::StaticOrder, true, true>(lds, g, S, E);
        }
        SEAM(pb + 4);
        if (KIND(6) && IN(pb + 5)) PROBE_LOOP(6) {
            KA a = get_args();
            MergeOrder S; S.base.init(Mmrg, DM, (int)gridDim.x, (int)blockIdx.x);
            pg8::Gemm g{(const bf16_t*)(a->ws + WS_Y), (const bf16_t*)(a->ws + WS_WBR), Mmrg, 4 * DM, 512, YP, 1024};
            if (PROBE_VAR == 7 && rep_ > 0) { EpiNull E{(float*)(a->ws + WS_LAM + 64)}; pg8::gemm_phase<EpiNull, MergeOrder, true, true>(lds, g, S, E); }
            else {
            EpiM E{(const bf16_t*)(a->ws + WS_QKV), (bf16_t*)(a->ws + WS_HN), (bf16_t*)(a->ws + WS_VT)};
            pg8::gemm_phase<EpiM, MergeOrder, true, true>(lds, g, S, E); }
            if (J < 0 && L == 0 && gridDim.x == 256 && blockIdx.x >= 32) {
                KA a2 = get_args(); WAVEIDS();
                convert_weights(a2, 1, lds, (int)(blockIdx.x - 32) * 8 + wid, 224 * 8, wid, lane, 0, 0, 5504);
            }
        }
        SEAM(pb + 5);
        if (KIND(7) && IN(pb + 6)) PROBE_LOOP(7) {
            KA a = get_args();
            pg8::Gemm g{(const bf16_t*)(a->ws + WS_HN), (const bf16_t*)(a->ws + WS_WO), Mmrg, DM, DM, DM, 0}; pg8::StaticOrder S; S.init(Mmrg, DM, (int)gridDim.x, (int)blockIdx.x);
            EpiOut E{(L == 0) ? a->in[0] : a->out, (L == 0) ? a->in[2] : (const float*)(a->ws + WS_XC1), a->out, (float*)(a->ws + WS_XC1), (const float*)(a->ws + WS_MOD) + (size_t)L * 9 * 3072};
            pg8::gemm_phase<EpiOut, pg8::StaticOrder, true, true>(lds, g, S, E);
            if (J < 0 && L == 0 && gridDim.x == 256 && blockIdx.x >= 32) {
                KA a2 = get_args(); WAVEIDS();
                convert_weights(a2, 1, lds, (int)(blockIdx.x - 32) * 8 + wid, 224 * 8, wid, lane, 0, 5504, 6528);
            }
        }
        if (L == 0) SEAM(pb + 6);
    }
#undef IN
#undef SEAM
#undef WAVEIDS
#undef KIND
}
template <int J> __global__ void __launch_bounds__(512, 2) fwd_kernel(Args a_unused) {
    extern __shared__ __attribute__((aligned(16))) unsigned char lds_raw[];
    run_phases<J>((lds_t*)lds_raw);
}

#if MK_ONE
#define MAINK fwd_kernel<-1>
#else
#define MAINK fwd_kernel<0>
#endif
extern "C" void kernel_launch(void* const* d_in, const int* in_sizes, int n_in, void* d_out, int out_size, void* d_ws, size_t ws_size, hipStream_t stream) {
    static int grid = 0;
    if (grid == 0) {
        if (n_in != 30 || out_size != NLAT * DM || ws_size < WS_END) { fprintf(stderr, "kernel_launch: unexpected problem (n_in %d, out %d, ws %zu < %zu)\n", n_in, out_size, ws_size, (size_t)WS_END); grid = -1; return; }
        int dev = 0, cus = 0, per_cu = 0;
        if (hipGetDevice(&dev) != hipSuccess || hipDeviceGetAttribute(&cus, hipDeviceAttributeMultiprocessorCount, dev) != hipSuccess) { grid = -1; return; }
        if (hipFuncSetAttribute((const void*)MAINK, hipFuncAttributeMaxDynamicSharedMemorySize, LDS_BYTES) != hipSuccess) { fprintf(stderr, "kernel_launch: hipFuncSetAttribute failed\n"); grid = -1; return; }
        if (hipOccupancyMaxActiveBlocksPerMultiprocessor(&per_cu, (const void*)MAINK, 512, LDS_BYTES) != hipSuccess || per_cu < 1) { fprintf(stderr, "kernel_launch: occupancy query gave %d\n", per_cu); per_cu = 1; }
        (void)hipGetLastError();
#if !MK_ONE
#define SETLDS(J) (void)hipFuncSetAttribute((const void*)fwd_kernel<J>, hipFuncAttributeMaxDynamicSharedMemorySize, LDS_BYTES)
        SETLDS(0); SETLDS(1); SETLDS(2); SETLDS(3); SETLDS(40); SETLDS(41); SETLDS(42); SETLDS(43); SETLDS(5); SETLDS(6); SETLDS(7);
#endif
        grid = cus;
    }
    if (grid < 0) return;
    Args a{};
    for (int i = 0; i < 30; ++i) a.in[i] = (const float*)d_in[i];
    a.out = (float*)d_out; a.ws = (unsigned char*)d_ws;
#if MK_ONE
    if (hipMemsetAsync((char*)d_ws + WS_BAR, 0, 16384, stream) != hipSuccess) { fprintf(stderr, "kernel_launch: memset of barrier words failed\n"); return; }
    a.ph_lo = 0; a.ph_hi = NPHASE;
    void* args[] = {&a};
    hipError_t e = hipLaunchCooperativeKernel((const void*)fwd_kernel<-1>, dim3(grid), dim3(512), args, LDS_BYTES, stream);
    if (e != hipSuccess) fprintf(stderr, "kernel_launch: cooperative launch failed: %s (grid %d)\n", hipGetErrorString(e), grid);
#else
#define LAUNCH1(J, p) do { a.ph_lo = (p); a.ph_hi = (p) + 1; hipLaunchKernelGGL(fwd_kernel<J>, dim3(grid), dim3(512), LDS_BYTES, stream, a); } while (0)
    LAUNCH1(0, 0);
    for (int L = 0; L < 2; ++L) { const int pb = 1 + 7 * L;
        LAUNCH1(1, pb + 0); LAUNCH1(2, pb + 1); LAUNCH1(3, pb + 2);
        LAUNCH1(42, pb + 3); LAUNCH1(40, pb + 3); LAUNCH1(41, pb + 3); LAUNCH1(43, pb + 3);
        LAUNCH1(5, pb + 4); LAUNCH1(6, pb + 5); LAUNCH1(7, pb + 6); }
#endif
}
```
